# Optimizing an MI355X kernel written in HIP

```python
import math
import jax, jax.numpy as jnp
from jax import lax
import numpy as np

D_MODEL = 2048
BATCH = 1
SEQ = 8192
DEPTH = 1

CHUNK = 64
MIX_WIDTH = D_MODEL
MIX_A = MIX_WIDTH // 2
MIX_B = MIX_WIDTH - MIX_A
POOL_WINDOWS = (2, 4, 8, 16)
N_POOL_GROUPS = len(POOL_WINDOWS)
POOL_CH = MIX_A // N_POOL_GROUPS
CONV_HEADS = 8
CONV_HEAD_DIM = MIX_B // CONV_HEADS
CONV_W = 3
IN_COLS = MIX_A + 3 * MIX_B
N_GROUPS = 4
E_PER_GROUP = 8
N_EXPERTS = N_GROUPS * E_PER_GROUP
TOP_K = 2
D_EXPERT = D_MODEL // 2
BLK = 128
EPS = 1e-6

kernel_name = "hybrid_pool_shortconv_hmoe"


def rmsnorm(x, g):
    xf = x.astype(jnp.float32)
    y = xf * lax.rsqrt(jnp.mean(xf * xf, axis=-1, keepdims=True) + EPS)
    return (y * g.astype(jnp.float32)).astype(x.dtype)


def multiscale_pool(u, w_pool, pool_scale):
    bt, s, _ = u.shape
    uf = u.astype(jnp.float32).reshape(bt, s, N_POOL_GROUPS, POOL_CH)
    cs = jnp.cumsum(uf, axis=1)
    steps = jnp.arange(1, s + 1)
    outs = []
    for gi, w in enumerate(POOL_WINDOWS):
        c = cs[:, :, gi]
        lagged = jnp.pad(c, ((0, 0), (w, 0), (0, 0)))[:, :s]
        cnt = jnp.minimum(steps, w).astype(jnp.float32)[None, :, None]
        outs.append((c - lagged) / cnt - uf[:, :, gi])
    pooled = jnp.stack(outs, axis=2).astype(u.dtype)
    mixed = jnp.einsum('bsgc,gcd->bsgd', pooled, w_pool)
    return mixed.reshape(bt, s, MIX_A) * pool_scale


def short_gated_conv(b_gate, c_gate, v, conv_w):
    s = v.shape[1]
    z = c_gate * v
    zp = jnp.pad(z, ((0, 0), (CONV_W - 1, 0), (0, 0)))
    y = zp[:, 0:s] * conv_w[:, 0]
    for k in range(1, CONV_W):
        y = y + zp[:, k:k + s] * conv_w[:, k]
    return b_gate * y


def hierarchical_moe(h, w_rg, b_rg, w_re, b_re, w_gate, w_up, w_down):
    bt, s, d = h.shape
    t = bt * s
    ht = h.reshape(t, d)
    g_prob = jax.nn.softmax((ht @ w_rg).astype(jnp.float32) + b_rg.astype(jnp.float32), axis=-1)
    grp = jnp.argmax(g_prob, axis=-1)
    g_w = jnp.take_along_axis(g_prob, grp[:, None], axis=-1)[:, 0]
    e_logits = ((ht @ w_re).astype(jnp.float32) + b_re.astype(jnp.float32)).reshape(t, N_GROUPS, E_PER_GROUP)
    e_sel = jnp.take_along_axis(e_logits, grp[:, None, None], axis=1)[:, 0]
    e_prob = jax.nn.softmax(e_sel, axis=-1)
    top_p, top_i = lax.top_k(e_prob, TOP_K)
    top_p = top_p / jnp.sum(top_p, axis=-1, keepdims=True)
    weights = g_w[:, None] * top_p
    expert_id = grp[:, None] * E_PER_GROUP + top_i

    a = t * TOP_K
    e_flat = expert_id.reshape(a).astype(jnp.int32)
    w_flat = weights.reshape(a)
    tok_flat = jnp.repeat(jnp.arange(t, dtype=jnp.int32), TOP_K)
    order = jnp.argsort(e_flat, stable=True)
    e_s, tok_s, w_s = e_flat[order], tok_flat[order], w_flat[order]
    counts = jnp.bincount(e_flat, length=N_EXPERTS)
    starts = jnp.cumsum(counts) - counts
    padded = ((counts + BLK - 1) // BLK) * BLK
    pstarts = jnp.cumsum(padded) - padded
    pends = pstarts + padded
    dest = pstarts[e_s] + (jnp.arange(a, dtype=jnp.int32) - starts[e_s])
    n_blocks = (a + N_EXPERTS * (BLK - 1) + BLK - 1) // BLK
    n_pad = n_blocks * BLK
    xbuf = jnp.zeros((n_pad, d), h.dtype).at[dest].set(ht[tok_s])
    blk_start = jnp.arange(n_blocks, dtype=jnp.int32) * BLK
    blk_expert = jnp.clip(jnp.sum(pends[None, :] <= blk_start[:, None], axis=1), 0, N_EXPERTS - 1)

    def expert_block(args):
        xb, e = args
        hid = jax.nn.silu(xb @ w_gate[e]) * (xb @ w_up[e])
        return hid @ w_down[e]

    ybuf = lax.map(expert_block, (xbuf.reshape(n_blocks, BLK, d), blk_expert)).reshape(n_pad, d)
    y_s = ybuf[dest] * w_s[:, None].astype(h.dtype)
    out = jnp.zeros((t, d), h.dtype).at[tok_s].add(y_s)
    return out.reshape(bt, s, d)


def setup_inputs(seed: int = 0) -> dict:
    key = jax.random.key(seed)
    ks = jax.random.split(key, 20)
    f32 = jnp.float32
    nrm = lambda k, shape, scale: jax.random.normal(k, shape, f32) * scale
    return {
        "x": nrm(ks[0], (BATCH, SEQ, D_MODEL), 1.0),
        "norm_mix_g": 1.0 + nrm(ks[1], (DEPTH, D_MODEL), 0.05),
        "w_in": nrm(ks[2], (DEPTH, D_MODEL, IN_COLS), D_MODEL ** -0.5),
        "w_pool": nrm(ks[3], (DEPTH, N_POOL_GROUPS, POOL_CH, POOL_CH), POOL_CH ** -0.5),
        "pool_scale": 1.0 + nrm(ks[4], (DEPTH, MIX_A), 0.1),
        "conv_w": nrm(ks[5], (DEPTH, MIX_B, CONV_W), CONV_W ** -0.5),
        "w_out": nrm(ks[6], (DEPTH, MIX_WIDTH, D_MODEL), MIX_WIDTH ** -0.5),
        "norm_ffn_g": 1.0 + nrm(ks[7], (DEPTH, D_MODEL), 0.05),
        "w_router_group": nrm(ks[8], (DEPTH, D_MODEL, N_GROUPS), D_MODEL ** -0.5),
        "b_router_group": nrm(ks[9], (DEPTH, N_GROUPS), 0.01),
        "w_router_expert": nrm(ks[10], (DEPTH, D_MODEL, N_EXPERTS), D_MODEL ** -0.5),
        "b_router_expert": nrm(ks[11], (DEPTH, N_EXPERTS), 0.01),
        "w_gate": nrm(ks[12], (DEPTH, N_EXPERTS, D_MODEL, D_EXPERT), D_MODEL ** -0.5),
        "w_up": nrm(ks[13], (DEPTH, N_EXPERTS, D_MODEL, D_EXPERT), D_MODEL ** -0.5),
        "w_down": nrm(ks[14], (DEPTH, N_EXPERTS, D_EXPERT, D_MODEL), D_EXPERT ** -0.5),
        "norm_final_g": 1.0 + nrm(ks[15], (D_MODEL,), 0.05),
    }


def reference(x, norm_mix_g, w_in, w_pool, pool_scale, conv_w, w_out, norm_ffn_g,
              w_router_group, b_router_group, w_router_expert, b_router_expert,
              w_gate, w_up, w_down, norm_final_g):
    for l in range(DEPTH):
        h = rmsnorm(x, norm_mix_g[l])
        proj = jnp.einsum('bsd,dc->bsc', h, w_in[l])
        u_pool = proj[..., :MIX_A]
        b_gate = proj[..., MIX_A:MIX_A + MIX_B]
        c_gate = proj[..., MIX_A + MIX_B:MIX_A + 2 * MIX_B]
        v = proj[..., MIX_A + 2 * MIX_B:]
        y_a = multiscale_pool(u_pool, w_pool[l], pool_scale[l])
        y_b = short_gated_conv(b_gate, c_gate, v, conv_w[l])
        mixed = jnp.concatenate([y_a, y_b], axis=-1)
        x = x + jnp.einsum('bsc,cd->bsd', mixed, w_out[l])
        h2 = rmsnorm(x, norm_ffn_g[l])
        x = x + hierarchical_moe(h2, w_router_group[l], b_router_group[l],
                                 w_router_expert[l], b_router_expert[l],
                                 w_gate[l], w_up[l], w_down[l])
    return rmsnorm(x, norm_final_g)
```

```cpp
#include <hip/hip_runtime.h>
#include <cstdio>
#include <cstdint>

#define LAS __attribute__((address_space(3)))
#define GAS __attribute__((address_space(1)))
typedef unsigned short bf16_t;
typedef short bf16x8 __attribute__((ext_vector_type(8)));
typedef float f32x4 __attribute__((ext_vector_type(4)));
typedef float f32x2 __attribute__((ext_vector_type(2)));
typedef unsigned u32x4 __attribute__((ext_vector_type(4)));
typedef unsigned u32x2 __attribute__((ext_vector_type(2)));
typedef int i32x4 __attribute__((ext_vector_type(4)));

#ifndef REP_P0
#define REP_P0 1
#endif
#ifndef REP_P1
#define REP_P1 1
#endif
#ifndef REP_P2
#define REP_P2 1
#endif
#ifndef REP_P3
#define REP_P3 1
#endif
#ifndef REP_P4
#define REP_P4 1
#endif
#ifndef REP_P5
#define REP_P5 1
#endif
#ifndef REP_P6
#define REP_P6 1
#endif
#ifndef REP_P7
#define REP_P7 1
#endif
#ifndef REP_P67
#define REP_P67 1
#endif
#ifndef REP_P8
#define REP_P8 1
#endif
constexpr int T = 8192, D = 2048, INC = 4096, MIXA = 1024, MIXB = 1024, NE = 32, DE = 1024, NGRP = 4, EPG = 8;
constexpr int POOLCH = 256, NRC = 36;
constexpr float EPS = 1e-6f;
constexpr int MAXSLOT = 24576;
constexpr int NWAVES = 8, NTHREADS = 512;

constexpr size_t MiB = 1u << 20;
constexpr size_t WS_CTL = 0, CTL_BYTES = 64 * 1024;
constexpr size_t WS_WRT = 1 * MiB;
constexpr size_t WS_WPOOL = 2 * MiB;
constexpr size_t WS_LIST = 3 * MiB;
constexpr size_t WS_ASG = 4 * MiB;
constexpr size_t WS_ASW = 5 * MiB;
constexpr size_t WS_WIN = 8 * MiB;
constexpr size_t WS_WOUT = 24 * MiB;
constexpr size_t WS_XN = 32 * MiB;
constexpr size_t WS_PROJ = 64 * MiB;
constexpr size_t WS_MIXED = 144 * MiB;
constexpr size_t WS_X1 = 176 * MiB;
constexpr size_t WS_HID = 240 * MiB;
constexpr size_t WS_Y = 288 * MiB;
constexpr size_t WS_END = 384 * MiB;
constexpr int CW_ECNT = 1024;
constexpr int CW_BAR = 4096;

constexpr int RING_BYTES = 135168;
constexpr int MISC_OFF = RING_BYTES;
constexpr int MISC_BAR = 0;
constexpr int MISC_ETAB = 16;
constexpr int MISC_NUNIT = 160;
constexpr int LDS_BYTES = 147456;

#define LDS_WAIT() asm volatile("s_waitcnt lgkmcnt(0)" ::: "memory")
#define VM_WAIT() asm volatile("s_waitcnt vmcnt(0)" ::: "memory")
#define RLX_AGENT __ATOMIC_RELAXED, __HIP_MEMORY_SCOPE_AGENT

__device__ __forceinline__ unsigned f2bf(float f) { unsigned u = __builtin_bit_cast(unsigned, f); return (u + 0x7fffu + ((u >> 16) & 1u)) >> 16; }
__device__ __forceinline__ unsigned pk2(float lo, float hi) { return f2bf(lo) | (f2bf(hi) << 16); }
__device__ __forceinline__ unsigned cvt_pk_bf16(float lo, float hi) { unsigned r; asm volatile("v_cvt_pk_bf16_f32 %0, %1, %2" : "=v"(r) : "v"(lo), "v"(hi)); return r; }
__device__ __forceinline__ float bflo(unsigned w) { return __builtin_bit_cast(float, w << 16); }
__device__ __forceinline__ float bfhi(unsigned w) { return __builtin_bit_cast(float, w & 0xffff0000u); }
__device__ __forceinline__ float wave_sum(float v) {
#pragma unroll
    for (int o = 1; o < 64; o <<= 1) v += __shfl_xor(v, o);
    return v;
}

__device__ __forceinline__ float wave_sum_dpp(float v) {
    v += __builtin_bit_cast(float, __builtin_amdgcn_update_dpp(0, __builtin_bit_cast(int, v), 0xB1, 0xF, 0xF, false));
    v += __builtin_bit_cast(float, __builtin_amdgcn_update_dpp(0, __builtin_bit_cast(int, v), 0x4E, 0xF, 0xF, false));
    v += __builtin_bit_cast(float, __builtin_amdgcn_update_dpp(0, __builtin_bit_cast(int, v), 0x141, 0xF, 0xF, false));
    v += __builtin_bit_cast(float, __builtin_amdgcn_update_dpp(0, __builtin_bit_cast(int, v), 0x140, 0xF, 0xF, false));
    v += __builtin_bit_cast(float, __builtin_amdgcn_update_dpp(0, __builtin_bit_cast(int, v), 0x142, 0xA, 0xF, false));
    v += __builtin_bit_cast(float, __builtin_amdgcn_update_dpp(0, __builtin_bit_cast(int, v), 0x143, 0xC, 0xF, false));
    return __builtin_bit_cast(float, __builtin_amdgcn_readlane(__builtin_bit_cast(int, v), 63));
}

#define XB_TMO      128
#define XB_XCNT(j)  (256  + 64 * (j))
#define XB_XSUB(j)  (1280 + 64 * (j))
#define XB_XGEN(j)  (2304 + 64 * (j))
#define XB_TOP      3328
#define XB_TOPGEN   3392
#define XCD_BAR_WORDS 3456
#define XB_SPIN_CAP (1u << 18)
__device__ __forceinline__ unsigned xb_ld(unsigned* p)              { return __hip_atomic_load(p, __ATOMIC_RELAXED, __HIP_MEMORY_SCOPE_AGENT); }
__device__ __forceinline__ unsigned xb_add(unsigned* p, unsigned v) { return __hip_atomic_fetch_add(p, v, __ATOMIC_RELAXED, __HIP_MEMORY_SCOPE_AGENT); }
__device__ __forceinline__ unsigned xb_xcc_id() { return (unsigned)__builtin_amdgcn_s_getreg((3 << 11) | 20) & 0xFu; }
#define XB_SPIN(cond, bar) do { unsigned _sp = 0; while (cond) { __builtin_amdgcn_s_sleep(1); \
    if ((++_sp & 255u) == 0u) { if (xb_ld(&(bar)[XB_TMO])) break; if (_sp > XB_SPIN_CAP) { atomicAdd(&(bar)[XB_TMO], 1u); break; } } } } while (0)
struct XcdBarrier { unsigned* bar; unsigned x; volatile LAS unsigned* st; };
__device__ __forceinline__ XcdBarrier xcd_barrier_post(unsigned* bar, volatile LAS unsigned* st) {
    XcdBarrier b; b.bar = bar; b.x = xb_xcc_id(); b.st = st;
    if (threadIdx.x == 0) (void)xb_add(&bar[XB_XCNT(b.x)], 1u);
    return b;
}
__device__ __forceinline__ void xcd_barrier_complete(unsigned* bar, unsigned x, unsigned& nloc, unsigned& nx) {
    const unsigned G = gridDim.x * gridDim.y * gridDim.z;
    unsigned sum, cnt, mine, sp = 0u;
    for (;;) {
        sum = 0u; cnt = 0u; mine = 0u;
#pragma unroll
        for (unsigned j = 0; j < 16; ++j) { const unsigned c = xb_ld(&bar[XB_XCNT(j)]); sum += c; cnt += (c > 0u) ? 1u : 0u; mine = (j == x) ? c : mine; }
        if (sum == G) break;
        __builtin_amdgcn_s_sleep(1);
        if ((++sp & 255u) == 0u) { if (xb_ld(&bar[XB_TMO])) break; if (sp > XB_SPIN_CAP) { atomicAdd(&bar[XB_TMO], 1u); break; } }
    }
    nloc = mine > 0u ? mine : 1u; nx = cnt > 0u ? cnt : 1u;
}
__device__ __forceinline__ void xcd_barrier(const XcdBarrier& b) {
    asm volatile("s_waitcnt vmcnt(0)" ::: "memory");
    __syncthreads();
    if (threadIdx.x == 0) {
        unsigned* bar = b.bar;
        __builtin_amdgcn_s_waitcnt(0);
        unsigned nloc = b.st[0], nx = b.st[1];
        if (nloc == 0u) { xcd_barrier_complete(bar, b.x, nloc, nx); b.st[0] = nloc; b.st[1] = nx; }
        const unsigned old = xb_add(&bar[XB_XSUB(b.x)], 1u);
        const unsigned gen = old / nloc;
        if (old + 1u == (gen + 1u) * nloc) {
            __builtin_amdgcn_fence(__ATOMIC_RELEASE, "agent");
            asm volatile("s_waitcnt vmcnt(0)" ::: "memory");
            const unsigned og = xb_add(&bar[XB_TOP], 1u);
            const unsigned tg = og / nx;
            if (og + 1u == (tg + 1u) * nx) xb_add(&bar[XB_TOPGEN], 1u);
            else XB_SPIN(xb_ld(&bar[XB_TOPGEN]) == tg, bar);
            __builtin_amdgcn_fence(__ATOMIC_ACQUIRE, "agent");
            xb_add(&bar[XB_XGEN(b.x)], 1u);
            asm volatile("s_waitcnt vmcnt(0)" ::: "memory");
        } else {
            XB_SPIN(xb_ld(&bar[XB_XGEN(b.x)]) == gen, bar);
            __builtin_amdgcn_fence(__ATOMIC_ACQUIRE, "agent");
            asm volatile("s_waitcnt vmcnt(0)" ::: "memory");
        }
    }
    __syncthreads();
}

namespace pg8 {
constexpr int BM = 256, BK = 64, HALF = 128, HTB = HALF * BK * 2, NXCD = 8, WGM = 8;
__host__ __device__ __forceinline__ int lds_byte(int r, int c) { const int st = (r >> 4) * 2 + (c >> 5), rr = r & 15, cc = c & 31, ob = rr * 64 + cc * 2; return st * 1024 + (ob ^ (((ob >> 9) & 1) << 5)); }
__host__ __device__ __forceinline__ void stage_rc(int b, int& R, int& C) { const int st = b / 1024, sb = b % 1024, swz = sb ^ (((sb >> 9) & 1) << 5); R = (st >> 1) * 16 + swz / 64; C = (st & 1) * 32 + (swz % 64) / 2; }
__host__ __device__ __forceinline__ int perm32(int rho) { const int n = rho >> 4, i = rho & 15; return 8 * (i >> 2) + 4 * n + (i & 3); }

struct Unit { int e, pm, pn, row0, nvalid, p0, p1, self; };

__device__ __forceinline__ bool static_order(int nM, int nN, int G, int c, int i, int& pm, int& pn) {
    const int nwg = nM * nN; const long L = (long)i * G + c; if (L >= nwg) return false;
    int wgid = (int)L; { const int q = nwg / NXCD, r = nwg % NXCD, xcd = wgid % NXCD, off = wgid / NXCD; wgid = (xcd < r ? xcd * (q + 1) : r * (q + 1) + (xcd - r) * q) + off; }
    const int nig = WGM * nN, gid = wgid / nig, fm = gid * WGM, gsz = (nM - fm) < WGM ? (nM - fm) : WGM;
    pm = fm + ((wgid % nig) % gsz); pn = (wgid % nig) / gsz; return true;
}

template <class Prob, class Epi, bool ALIGN_EPI>
__device__ __forceinline__ void gemm_phase(LAS unsigned char* lds, const Prob& P, const Epi& E) {
    int tid_ = threadIdx.x; asm volatile("" : "+v"(tid_));
    const int tid = tid_, wid = __builtin_amdgcn_readfirstlane(tid >> 6), lane = tid & 63, wr = wid >> 2, wc = wid & 3, fr = lane & 15, fq = lane >> 4;
    const int K = P.K, nt = K / BK;
    int Rr[2], Cc[2];
    unsigned voffA[2][2], voffB[2], nvoffA[2][2];
#pragma unroll
    for (int i = 0; i < 2; ++i) { stage_rc(tid * 16 + i * 8192, Rr[i], Cc[i]); const int Rb = Epi::PERM ? ((Rr[i] & ~31) + perm32(Rr[i] & 31)) : Rr[i];
        voffB[i] = (unsigned)(Rb * P.ldb + Cc[i]) * 2u;
        voffA[0][i] = (unsigned)(Rr[i] * P.lda + Cc[i]) * 2u; voffA[1][i] = (unsigned)((Rr[i] + HALF) * P.lda + Cc[i]) * 2u; }
    const size_t kstep = (size_t)(BK * 2);
    const size_t hstepB = (size_t)HALF * P.ldb * 2;
    const unsigned ldsw = (unsigned)wid * 1024u;
    const int aoff = lds_byte(wr * 64 + fr, fq * 8), boff = lds_byte(wc * 32 + fr, fq * 8);
#define PG8_SA(b, h) (((b) * 2 + (h)) * HTB)
#define PG8_SB(b, h) ((4 + (b) * 2 + (h)) * HTB)
#define PG8_STAGE(bufoff, gbase, voff) do { _Pragma("unroll") for (int _i = 0; _i < 2; ++_i) \
        __builtin_amdgcn_global_load_lds((const unsigned*)((const char*)(gbase) + (voff)[_i]), (LAS unsigned*)(lds + (bufoff) + ldsw + _i * 8192), 16, 0, 0); } while (0)
#define PG8_LDA(dst, b, h) do { _Pragma("unroll") for (int m = 0; m < 4; ++m) _Pragma("unroll") for (int k = 0; k < 2; ++k) dst[m][k] = *(const LAS bf16x8*)(lds + PG8_SA(b, h) + aoff + m * 2048 + k * 1024); } while (0)
#define PG8_LDB(dst, b, h) do { _Pragma("unroll") for (int n = 0; n < 2; ++n) _Pragma("unroll") for (int k = 0; k < 2; ++k) dst[n][k] = *(const LAS bf16x8*)(lds + PG8_SB(b, h) + boff + n * 2048 + k * 1024); } while (0)
#define PG8_MMA(ai, bj, At, Bt) do { __builtin_amdgcn_s_setprio(1); _Pragma("unroll") for (int m = 0; m < 4; ++m) _Pragma("unroll") for (int n = 0; n < 2; ++n) _Pragma("unroll") for (int k = 0; k < 2; ++k) \
        acc[ai][bj][m][n] = __builtin_amdgcn_mfma_f32_16x16x32_bf16(Bt[n][k], At[m][k], acc[ai][bj][m][n], 0, 0, 0); __builtin_amdgcn_s_setprio(0); } while (0)
#define PG8_WAIT_V(n) asm volatile("s_waitcnt vmcnt(" #n ")" ::: "memory")
#define PG8_WAIT_L(n) asm volatile("s_waitcnt lgkmcnt(" #n ")" ::: "memory")
#define PG8_BAR __builtin_amdgcn_s_barrier()
#define PG8_SCHED __builtin_amdgcn_sched_barrier(0)
    Unit cur, nxt; int ui = 0;
    if (!P.next(0, cur)) return;
    f32x4 acc[2][2][4][2];
#pragma unroll
    for (int a = 0; a < 2; ++a)
#pragma unroll
        for (int b = 0; b < 2; ++b)
#pragma unroll
            for (int m = 0; m < 4; ++m)
#pragma unroll
                for (int n = 0; n < 2; ++n) acc[a][b][m][n] = (f32x4){0.f, 0.f, 0.f, 0.f};
    bf16x8 At[4][2], B0[2][2], B1[2][2];
    const char* cA = P.a_base(cur); const char* cB = P.b_base(cur);
    if constexpr (Prob::GATHER) P.a_voff(cur, Rr, Cc, voffA);
    PG8_STAGE(PG8_SB(0, 0), cB, voffB); PG8_STAGE(PG8_SB(0, 1), cB + hstepB, voffB); PG8_STAGE(PG8_SA(0, 0), cA, voffA[0]); PG8_STAGE(PG8_SA(0, 1), cA, voffA[1]);
    if (wr == 1) PG8_BAR;
    PG8_WAIT_V(2); PG8_BAR;
    PG8_STAGE(PG8_SB(1, 0), cB + kstep, voffB); PG8_STAGE(PG8_SA(1, 0), cA + kstep, voffA[0]); PG8_STAGE(PG8_SB(1, 1), cB + hstepB + kstep, voffB);
    PG8_WAIT_V(6); PG8_BAR;
    for (;;) {
        const bool has_next = P.next(ui + 1, nxt);
        const char* nA = has_next ? P.a_base(nxt) : cA; const char* nB = has_next ? P.b_base(nxt) : cB;
        if constexpr (Prob::GATHER) {
            if (has_next) P.a_voff(nxt, Rr, Cc, nvoffA);
            else { nvoffA[0][0] = voffA[0][0]; nvoffA[0][1] = voffA[0][1]; nvoffA[1][0] = voffA[1][0]; nvoffA[1][1] = voffA[1][1]; }
        }
        for (int t = 0; t < nt; t += 2) {
            const bool last = (t == nt - 2);
            const char* a1 = cA + (size_t)(t + 1) * kstep;
            const char* a2 = last ? nA : cA + (size_t)(t + 2) * kstep; const char* b2 = last ? nB : cB + (size_t)(t + 2) * kstep;
            const char* a3 = a2 + kstep; const char* b3 = b2 + kstep;
            PG8_LDB(B0, 0, 0); PG8_LDB(B1, 0, 1); PG8_SCHED; PG8_LDA(At, 0, 0); PG8_STAGE(PG8_SA(1, 1), a1, voffA[1]);
            if constexpr (Prob::GATHER) { if (last) { voffA[0][0] = nvoffA[0][0]; voffA[0][1] = nvoffA[0][1]; voffA[1][0] = nvoffA[1][0]; voffA[1][1] = nvoffA[1][1]; } }
            PG8_WAIT_V(8); PG8_WAIT_L(0); PG8_BAR; PG8_MMA(0, 0, At, B0); PG8_MMA(0, 1, At, B1); PG8_BAR; PG8_SCHED;
            PG8_LDA(At, 0, 1); PG8_STAGE(PG8_SB(0, 0), b2, voffB); PG8_STAGE(PG8_SB(0, 1), b2 + hstepB, voffB); PG8_STAGE(PG8_SA(0, 0), a2, voffA[0]);
            PG8_WAIT_V(8); PG8_WAIT_L(0); PG8_BAR; PG8_MMA(1, 0, At, B0); PG8_MMA(1, 1, At, B1); PG8_BAR; PG8_SCHED;
            PG8_LDB(B0, 1, 0); PG8_LDB(B1, 1, 1); PG8_SCHED; PG8_LDA(At, 1, 0); PG8_STAGE(PG8_SA(0, 1), a2, voffA[1]);
            PG8_WAIT_V(8); PG8_WAIT_L(0); PG8_BAR; PG8_MMA(0, 0, At, B0); PG8_MMA(0, 1, At, B1); PG8_BAR; PG8_SCHED;
            PG8_LDA(At, 1, 1); PG8_STAGE(PG8_SB(1, 0), b3, voffB); PG8_STAGE(PG8_SB(1, 1), b3 + hstepB, voffB); PG8_STAGE(PG8_SA(1, 0), a3, voffA[0]);
            PG8_WAIT_V(8); PG8_WAIT_L(0); PG8_BAR; PG8_MMA(1, 0, At, B0); PG8_MMA(1, 1, At, B1); PG8_BAR; PG8_SCHED;
        }
        if constexpr (ALIGN_EPI) { if (wr == 0) PG8_BAR; }
        if constexpr (Epi::DRAIN_FIRST) __builtin_amdgcn_s_waitcnt(0x0F70);
        E(acc, cur, wr, wc, fr, fq);
        if (!has_next) break;
#pragma unroll
        for (int a = 0; a < 2; ++a)
#pragma unroll
            for (int b = 0; b < 2; ++b)
#pragma unroll
                for (int m = 0; m < 4; ++m)
#pragma unroll
                    for (int n = 0; n < 2; ++n) acc[a][b][m][n] = (f32x4){0.f, 0.f, 0.f, 0.f};
        cur = nxt; cA = nA; cB = nB; ++ui;
        if constexpr (ALIGN_EPI) { if (wr == 1) PG8_BAR; }
    }
    PG8_WAIT_V(0);
    if constexpr (!ALIGN_EPI) { if (wr == 0) PG8_BAR; }
    PG8_BAR;
#undef PG8_SA
#undef PG8_SB
#undef PG8_STAGE
#undef PG8_LDA
#undef PG8_LDB
#undef PG8_MMA
#undef PG8_WAIT_V
#undef PG8_WAIT_L
#undef PG8_BAR
#undef PG8_SCHED
}
}
using pg8::Unit;

struct ProbDense {
    static constexpr bool GATHER = false;
    const bf16_t* A; const bf16_t* Bt; int K, lda, ldb, nM, nN, G, c;
    __device__ __forceinline__ bool next(int i, Unit& u) const { u.e = 0; u.row0 = 0; u.nvalid = 256; return pg8::static_order(nM, nN, G, c, i, u.pm, u.pn); }
    __device__ __forceinline__ const char* a_base(const Unit& u) const { return (const char*)(A + (size_t)u.pm * 256 * lda); }
    __device__ __forceinline__ const char* b_base(const Unit& u) const { return (const char*)(Bt + (size_t)u.pn * 256 * ldb); }
    __device__ __forceinline__ void a_voff(const Unit&, const int*, const int*, unsigned (&)[2][2]) const {}
};
struct ProbWeff {
    static constexpr bool GATHER = false;
    const bf16_t* A; const bf16_t* Bt; int K, lda, ldb, G, c;
    __device__ __forceinline__ bool next(int i, Unit& u) const { const int L = i * G + c; if (L >= 32) return false; u.pm = L & 7; u.e = L >> 3; u.pn = 0; u.row0 = 0; u.nvalid = 256; return true; }
    __device__ __forceinline__ const char* a_base(const Unit& u) const { return (const char*)(A + (size_t)u.pm * 256 * lda + u.e * 256); }
    __device__ __forceinline__ const char* b_base(const Unit& u) const { return (const char*)(Bt + (size_t)u.e * 256 * 256); }
    __device__ __forceinline__ void a_voff(const Unit&, const int*, const int*, unsigned (&)[2][2]) const {}
};
struct EpiBf16 {
    static constexpr bool PERM = true, DRAIN_FIRST = false;
    bf16_t* O; int ldc; const float* scale; int mode;
    __device__ __forceinline__ void operator()(const f32x4 (&acc)[2][2][4][2], const Unit& u, int wr, int wc, int fr, int fq) const {
        const int rb = (mode == 2 ? u.row0 : u.pm * 256) + wr * 64 + fr; const int cb = (mode == 1 ? u.e * 256 : u.pn * 256) + wc * 32 + 8 * fq;
        f32x4 sv[2][2];
#pragma unroll
        for (int bj = 0; bj < 2; ++bj)
#pragma unroll
            for (int n = 0; n < 2; ++n) sv[bj][n] = scale ? *(const f32x4*)(scale + cb + bj * 128 + 4 * n) : (f32x4){1.f, 1.f, 1.f, 1.f};
#pragma unroll
        for (int ai = 0; ai < 2; ++ai)
#pragma unroll
            for (int m = 0; m < 4; ++m) { bf16_t* rowp = O + (size_t)(rb + ai * 128 + m * 16) * ldc + cb;
#pragma unroll
                for (int bj = 0; bj < 2; ++bj) { const f32x4 v0 = acc[ai][bj][m][0] * sv[bj][0], v1 = acc[ai][bj][m][1] * sv[bj][1];
                    u32x4 w; w.x = cvt_pk_bf16(v0[0], v0[1]); w.y = cvt_pk_bf16(v0[2], v0[3]); w.z = cvt_pk_bf16(v1[0], v1[1]); w.w = cvt_pk_bf16(v1[2], v1[3]);
                    *(u32x4*)(rowp + bj * 128) = w; } }
    }
};
struct EpiResF32 {
    static constexpr bool PERM = false, DRAIN_FIRST = true;
    const float* base; float* out; int ldc;
    __device__ __forceinline__ void operator()(const f32x4 (&acc)[2][2][4][2], const Unit& u, int wr, int wc, int fr, int fq) const {
        const int rb = u.pm * 256 + wr * 64 + fr, cb = u.pn * 256 + wc * 32 + 4 * fq;
#pragma unroll
        for (int ai = 0; ai < 2; ++ai) {
            f32x4 bs[4][2][2];
#pragma unroll
            for (int m = 0; m < 4; ++m) { const size_t off = (size_t)(rb + ai * 128 + m * 16) * ldc + cb;
#pragma unroll
                for (int bj = 0; bj < 2; ++bj)
#pragma unroll
                    for (int n = 0; n < 2; ++n) bs[m][bj][n] = *(const f32x4*)(base + off + bj * 128 + n * 16); }
            asm volatile("" ::: "memory");
#pragma unroll
            for (int m = 0; m < 4; ++m) { const size_t off = (size_t)(rb + ai * 128 + m * 16) * ldc + cb;
#pragma unroll
                for (int bj = 0; bj < 2; ++bj)
#pragma unroll
                    for (int n = 0; n < 2; ++n) *(f32x4*)(out + off + bj * 128 + n * 16) = bs[m][bj][n] + acc[ai][bj][m][n]; }
            asm volatile("" ::: "memory");
        }
    }
};
__device__ __forceinline__ float silu_mul(float g, float u) { const float e = __builtin_amdgcn_exp2f(g * -1.44269504089f); return g * __builtin_amdgcn_rcpf(1.0f + e) * u; }
namespace tt { constexpr int MAXRB = 36, STAGE = (MAXRB + 8) * 1024, NST = 3; }
struct Args { const float* in[16]; float* out; unsigned char* ws; };

__device__ __forceinline__ int swz_f(int r) { return ((r >> 1) & 7) ^ (((r >> 2) ^ (r >> 3)) & 1) ^ ((r >> 4) & 1); }
struct CvtTile { const float* src; bf16_t* dst; int ldw, ldt, n0; };
__device__ __forceinline__ CvtTile cvt_decode(int it, const float* w_in, const float* w_out, bf16_t* WIN, bf16_t* WOUT) {
    CvtTile t;
    constexpr int I_IN = 32 * 16;
    if (it < I_IN) { const int kb = it / 16, nb = it % 16; t.src = w_in + (size_t)(64 * kb) * INC + 256 * nb; t.dst = WIN + 64 * kb; t.ldw = INC; t.ldt = D; t.n0 = 256 * nb; return t; }
    const int r = it - I_IN, kb = r / 8, nb = r % 8; t.src = w_out + (size_t)(64 * kb) * D + 256 * nb; t.dst = WOUT + 64 * kb; t.ldw = D; t.ldt = D; t.n0 = 256 * nb;
    return t;
}
constexpr int CVT_NTILES = 32 * 16 + 32 * 8;

namespace tt8 {
using pg8::Unit;
constexpr int MAXRB = tt::MAXRB, STAGE = tt::STAGE, NST = tt::NST;
constexpr float SC_A = 8.0f, SC_B = 32.0f, SC_INV = 1.0f / (SC_A * SC_B);
__device__ __forceinline__ unsigned pack4_fp8(float a, float b, float c, float d) { int v = __builtin_amdgcn_cvt_pk_fp8_f32(a, b, 0, false); v = __builtin_amdgcn_cvt_pk_fp8_f32(c, d, v, true); return (unsigned)v; }
template <class Prob, class Epi>
__device__ __forceinline__ void gemm_phase(LAS unsigned char* lds, const Prob& P, const Epi& E) {
    int tid_ = threadIdx.x; asm volatile("" : "+v"(tid_));
    const int tid = tid_, wid = __builtin_amdgcn_readfirstlane(tid >> 6), lane = tid & 63, fr = lane & 15, fq = lane >> 4, wm = wid >> 1, wn = wid & 1;
    const int nt = P.K / 64;
    const int Rl = lane >> 2, Cb = 16 * ((lane & 3) ^ ((Rl >> 2) & 3));
    const int swr = ((fr >> 2) & 3) << 1, roff0 = fr * 64 + ((fq ^ swr) << 3), roff1 = fr * 64 + (((4 + fq) ^ swr) << 3);
    const int cq = lane & 31, kq = 2 * wid + (lane >> 5);
    int bw; { const int tc0 = 4 * cq, c32 = tc0 & 31, a_ = c32 >> 3, b_ = (c32 >> 2) & 1, rho0 = (tc0 & ~31) + 16 * b_ + 4 * a_;
        bw = (MAXRB + (rho0 >> 4)) * 1024 + (rho0 & 15) * 64 + ((((kq >> 1) ^ (a_ << 1)) & 7) << 3) + 4 * (kq & 1); }
    Unit u;
    for (int ui = 0; P.next(ui, u); ++ui) {
        const int RB = (u.nvalid + 15) >> 4, nblk = (RB - wm + 3) >> 2;
        const char* cA = P.a_base(u);
        const float* lB = P.b_base(u, cq >> 4) + 4 * (cq & 15) + (size_t)(4 * kq) * P.ldw;
        unsigned voffA[5]; int pidx[5];
#pragma unroll
        for (int i = 0; i < 5; ++i) { int p = wid + 8 * i; p = p < RB ? p : RB - 1; pidx[i] = p; voffA[i] = P.a_voff(u, 16 * p + Rl, Cb); }
        f32x4 acc[9][4];
#pragma unroll
        for (int i = 0; i < 9; ++i)
#pragma unroll
            for (int n = 0; n < 4; ++n) acc[i][n] = (f32x4){0.f, 0.f, 0.f, 0.f};
        f32x4 b0[4];
#define TT8_STAGE_A(st, kt) do { LAS unsigned char* sb_ = lds + (st) * STAGE; _Pragma("unroll") for (int i_ = 0; i_ < 5; ++i_) \
            __builtin_amdgcn_global_load_lds((const unsigned*)(cA + (size_t)(kt) * P.a_kstep + voffA[i_]), (LAS unsigned*)(sb_ + pidx[i_] * 1024), 16, 0, 0); } while (0)
#define TT8_LOAD_B(set, kt) do { const float* r_ = lB + (size_t)(kt) * 64 * P.ldw; _Pragma("unroll") for (int j_ = 0; j_ < 4; ++j_) { const float* p_ = r_ + (size_t)j_ * P.ldw; \
            asm volatile("global_load_dwordx4 %0, %1, off" : "=v"(set[j_]) : "v"(p_) : "memory"); } } while (0)
#define TT8_WRITE_B(set, st) do { _Pragma("unroll") for (int c_ = 0; c_ < 4; ++c_) \
            *(LAS unsigned*)(lds + (st) * STAGE + bw + 64 * c_) = pack4_fp8(set[0][c_] * SC_B, set[1][c_] * SC_B, set[2][c_] * SC_B, set[3][c_] * SC_B); } while (0)
#define TT8_WAIT(n, set) asm volatile("s_waitcnt vmcnt(" #n ")" : "+v"(set[0]), "+v"(set[1]), "+v"(set[2]), "+v"(set[3]) :: "memory")
        asm volatile("s_waitcnt vmcnt(0) lgkmcnt(0)" ::: "memory"); __builtin_amdgcn_s_barrier();
        TT8_LOAD_B(b0, 0); TT8_STAGE_A(0, 0);
        TT8_WAIT(5, b0); TT8_WRITE_B(b0, 0);
        TT8_LOAD_B(b0, 1); TT8_STAGE_A(1, 1);
        int st = 0;
#define TT8_AF(dst, g_) do { _Pragma("unroll") for (int i = 0; i < 3; ++i) { dst[i][0] = *(const LAS long*)(sa_ + (4 * (3 * (g_) + i) + wm) * 1024 + roff0); dst[i][1] = *(const LAS long*)(sa_ + (4 * (3 * (g_) + i) + wm) * 1024 + roff1); } } while (0)
#define TT8_MM(src, g_) do { __builtin_amdgcn_s_setprio(1); \
            _Pragma("unroll") for (int i = 0; i < 3; ++i) { if (3 * (g_) + i < nblk) { _Pragma("unroll") for (int ks = 0; ks < 2; ++ks) _Pragma("unroll") for (int nb = 0; nb < 4; ++nb) \
                acc[3 * (g_) + i][nb] = __builtin_amdgcn_mfma_f32_16x16x32_fp8_fp8(bf_[nb][ks], src[i][ks], acc[3 * (g_) + i][nb], 0, 0, 0); } } \
            __builtin_amdgcn_s_setprio(0); } while (0)
#define TT8_STEP(t, SET) do { \
            TT8_WAIT(5, SET); asm volatile("s_waitcnt lgkmcnt(0)" ::: "memory"); __builtin_amdgcn_s_barrier();     \
            int s1_ = st + 1; s1_ = s1_ >= NST ? s1_ - NST : s1_; int s2_ = s1_ + 1; s2_ = s2_ >= NST ? s2_ - NST : s2_; \
            TT8_WRITE_B(SET, s1_); \
            { const int t3_ = (t) + 2 < nt ? (t) + 2 : nt - 1; TT8_LOAD_B(SET, t3_); } \
            { const int t2_ = (t) + 2 < nt ? (t) + 2 : nt - 1; TT8_STAGE_A(s2_, t2_); } \
            const LAS unsigned char* sa_ = lds + st * STAGE; \
            long bf_[4][2]; _Pragma("unroll") for (int nb = 0; nb < 4; ++nb) { bf_[nb][0] = *(const LAS long*)(sa_ + (MAXRB + Prob::bsub(wn, nb)) * 1024 + roff0); bf_[nb][1] = *(const LAS long*)(sa_ + (MAXRB + Prob::bsub(wn, nb)) * 1024 + roff1); } \
            long afa_[3][2], afb_[3][2]; \
            TT8_AF(afa_, 0); TT8_AF(afb_, 1);        \
            TT8_MM(afa_, 0); \
            TT8_AF(afa_, 2); \
            TT8_MM(afb_, 1); \
            TT8_MM(afa_, 2); \
            st = s1_; } while (0)
        for (int t = 0; t < nt; ++t) { TT8_STEP(t, b0); }
        TT8_WAIT(0, b0);
        E(acc, u, RB, wm, wn, fr, fq);
#undef TT8_STAGE_A
#undef TT8_LOAD_B
#undef TT8_WRITE_B
#undef TT8_WAIT
#undef TT8_STEP
#undef TT8_AF
#undef TT8_MM
    }
    asm volatile("s_waitcnt vmcnt(0) lgkmcnt(0)" ::: "memory"); __builtin_amdgcn_s_barrier();
}
}
struct ProbTT8a {
    const unsigned char* A; const float* Wg; const float* Wu; const int* list; int K, lda, ldw; const volatile LAS int* ul; int nunits; static constexpr size_t a_kstep = 64;
    __device__ __forceinline__ bool next(int i, Unit& u) const { if (i >= nunits) return false; u.e = __builtin_amdgcn_readfirstlane(ul[8 * i]); u.pn = __builtin_amdgcn_readfirstlane(ul[8 * i + 1]);
        u.pm = __builtin_amdgcn_readfirstlane(ul[8 * i + 2]); u.row0 = __builtin_amdgcn_readfirstlane(ul[8 * i + 3]); u.nvalid = __builtin_amdgcn_readfirstlane(ul[8 * i + 4]); return true; }
    __device__ __forceinline__ const char* a_base(const Unit&) const { return (const char*)A; }
    __device__ __forceinline__ const float* b_base(const Unit& u, int par) const { return (par ? Wu : Wg) + (size_t)u.e * K * ldw + 64 * u.pn; }
    __device__ __forceinline__ unsigned a_voff(const Unit& u, int r, int cb) const { const int last = u.nvalid - 1; r = r < last ? r : last; const int tok = list[(size_t)u.e * T + u.pm * 576 + r]; return (unsigned)(tok * lda + cb); }
    static __device__ __forceinline__ int bsub(int wn, int nb) { return (nb >> 1) * 4 + 2 * wn + (nb & 1); }
};
struct EpiTT8Swiglu {
    unsigned char* O; int ldc;
    __device__ __forceinline__ void operator()(const f32x4 (&acc)[9][4], const Unit& u, int RB, int wm, int wn, int fr, int fq) const {
        unsigned char* base = O + ((size_t)u.pn * MAXSLOT + (size_t)(u.row0 + fr)) * 64 + 32 * wn + 8 * fq;
#pragma unroll
        for (int i = 0; i < 9; ++i) if (4 * i + wm < RB) {
            const f32x4 g0 = acc[i][0] * tt8::SC_INV, g1 = acc[i][1] * tt8::SC_INV, u0 = acc[i][2] * (tt8::SC_INV * tt8::SC_A), u1 = acc[i][3] * (tt8::SC_INV * tt8::SC_A);
#define SMC(g_, u_) __builtin_amdgcn_fmed3f(silu_mul(g_, u_), -440.0f, 440.0f)
            u32x2 w; w.x = tt8::pack4_fp8(SMC(g0[0], u0[0]), SMC(g0[1], u0[1]), SMC(g0[2], u0[2]), SMC(g0[3], u0[3]));
            w.y = tt8::pack4_fp8(SMC(g1[0], u1[0]), SMC(g1[1], u1[1]), SMC(g1[2], u1[2]), SMC(g1[3], u1[3]));
#undef SMC
            *(u32x2*)(base + (size_t)(16 * (4 * i + wm)) * 64) = w; }
    }
};
struct ProbTT8b {
    const unsigned char* A; const float* W; int K, lda, ldw; const volatile LAS int* ul; int nunits; static constexpr size_t a_kstep = (size_t)MAXSLOT * 64;
    __device__ __forceinline__ bool next(int i, Unit& u) const { if (i >= nunits) return false; u.e = __builtin_amdgcn_readfirstlane(ul[8 * i]); u.pn = __builtin_amdgcn_readfirstlane(ul[8 * i + 1]);
        u.pm = __builtin_amdgcn_readfirstlane(ul[8 * i + 2]); u.row0 = __builtin_amdgcn_readfirstlane(ul[8 * i + 3]); u.nvalid = __builtin_amdgcn_readfirstlane(ul[8 * i + 4]); return true; }
    __device__ __forceinline__ const char* a_base(const Unit& u) const { return (const char*)(A + (size_t)u.row0 * 64); }
    __device__ __forceinline__ const float* b_base(const Unit& u, int par) const { return W + (size_t)u.e * K * ldw + 128 * u.pn + 64 * par; }
    __device__ __forceinline__ unsigned a_voff(const Unit& u, int r, int cb) const { const int last = u.nvalid - 1; r = r < last ? r : last; return (unsigned)(r * 64 + cb); }
    static __device__ __forceinline__ int bsub(int wn, int nb) { return 4 * wn + nb; }
};
struct EpiTT8Y {
    bf16_t* O; int ldc;
    __device__ __forceinline__ void operator()(const f32x4 (&acc)[9][4], const Unit& u, int RB, int wm, int wn, int fr, int fq) const {
        bf16_t* base = O + (size_t)(u.row0 + fr) * ldc + 128 * u.pn + 64 * wn + 8 * fq;
#pragma unroll
        for (int i = 0; i < 9; ++i) if (4 * i + wm < RB) {
#pragma unroll
            for (int h = 0; h < 2; ++h) { const f32x4 a0 = acc[i][2 * h] * tt8::SC_INV, a1 = acc[i][2 * h + 1] * tt8::SC_INV;
                u32x4 w; w.x = cvt_pk_bf16(a0[0], a0[1]); w.y = cvt_pk_bf16(a0[2], a0[3]); w.z = cvt_pk_bf16(a1[0], a1[1]); w.w = cvt_pk_bf16(a1[2], a1[3]);
                *(u32x4*)(base + (size_t)(16 * (4 * i + wm)) * ldc + 32 * h) = w; } }
    }
};

__device__ __forceinline__ int build_tt_units(volatile LAS int* misc, unsigned* ctl, int vcu, int G) {
    volatile LAS int* cnt = misc + MISC_ETAB; volatile LAS int* nmt = cnt + 32; volatile LAS int* pst = nmt + 32;
    volatile LAS int* ul = misc + MISC_NUNIT + 8;
    int tid = threadIdx.x; asm volatile("" : "+v"(tid));
    __syncthreads();
    if (tid < 32) { const int c = (int)__hip_atomic_load(ctl + CW_ECNT + 64 * tid, RLX_AGENT); cnt[tid] = c; nmt[tid] = (c + 255) >> 8; }
    __syncthreads();
    if (tid == 0) {
        volatile LAS int* ubt = pst + 33;
        int p = 0, q = 0; for (int e = 0; e < 32; ++e) { pst[e] = p; ubt[e] = q; p += nmt[e] * 256; q += 16 * ((cnt[e] + 575) / 576); } pst[32] = p; ubt[32] = q;
        int n = 0, e = 0;
        for (int L = vcu; L < q; L += G) {
            while (L >= ubt[e + 1]) ++e;
            const int r = L - ubt[e], rc = r >> 4, pn = r & 15, nv = cnt[e] - 576 * rc;
            ul[8 * n] = e; ul[8 * n + 1] = pn; ul[8 * n + 2] = rc; ul[8 * n + 3] = pst[e] + 576 * rc; ul[8 * n + 4] = nv < 576 ? nv : 576;
            ul[8 * n + 5] = (pn > 0 && (L - pn) / G == L / G) ? 16 * (L - pn) : -1; ul[8 * n + 6] = -1; ul[8 * n + 7] = 16 * L;
            ++n;
        }
        misc[MISC_NUNIT] = n;
    }
    __syncthreads();
    return misc[MISC_NUNIT];
}

__global__ void __launch_bounds__(NTHREADS, 2) fwd_kernel(Args args) {
    extern __shared__ __attribute__((aligned(16))) unsigned char lds_raw[];
    LAS unsigned char* lds = (LAS unsigned char*)lds_raw;
    volatile LAS int* misc = (volatile LAS int*)(lds + MISC_OFF);
    const int tid = threadIdx.x, lane = tid & 63, wave = __builtin_amdgcn_readfirstlane(tid >> 6);
    const int G = gridDim.x, bx = blockIdx.x;
    const int vcu = (G % 8 == 0) ? (bx % 8) * (G / 8) + bx / 8 : bx;
    const int gw = vcu * NWAVES + wave, NGW = G * NWAVES;

    unsigned char* ws = args.ws;
    unsigned* ctl = (unsigned*)(ws + WS_CTL);
    const float* x = args.in[0]; const float* g1 = args.in[1]; const float* w_in = args.in[2]; const float* w_pool = args.in[3]; const float* pool_scale = args.in[4];
    const float* conv_w = args.in[5]; const float* w_out = args.in[6]; const float* g2 = args.in[7]; const float* w_rg = args.in[8]; const float* b_rg = args.in[9];
    const float* w_re = args.in[10]; const float* b_re = args.in[11]; const float* w_gate = args.in[12]; const float* w_up = args.in[13]; const float* w_down = args.in[14];
    const float* g3 = args.in[15];
    float* out = args.out;
    bf16_t* WRTH = (bf16_t*)(ws + WS_WRT + 512 * 1024); bf16_t* WRTL = (bf16_t*)(ws + WS_WRT + 768 * 1024); bf16_t* WPOOL = (bf16_t*)(ws + WS_WPOOL); int* LIST = (int*)(ws + WS_LIST); i32x4* ASG = (i32x4*)(ws + WS_ASG); f32x2* ASW = (f32x2*)(ws + WS_ASW);
    bf16_t* WIN = (bf16_t*)(ws + WS_WIN); bf16_t* WOUT = (bf16_t*)(ws + WS_WOUT); bf16_t* XN = (bf16_t*)(ws + WS_XN); bf16_t* PROJ = (bf16_t*)(ws + WS_PROJ);
    bf16_t* MIXED = (bf16_t*)(ws + WS_MIXED); bf16_t* MIXO = (bf16_t*)(ws + WS_X1); bf16_t* HID = (bf16_t*)(ws + WS_HID);
    bf16_t* Y = (bf16_t*)(ws + WS_Y);

    for (int u = tid; u < 1024; u += NTHREADS) misc[u] = 0;
    __syncthreads();
    XcdBarrier bar = xcd_barrier_post(ctl + CW_BAR, (volatile LAS unsigned*)(misc + MISC_BAR));

    for (int rep_ = 0; rep_ < REP_P0; ++rep_) {
    {
        {
            int it = vcu;
            f32x4 v[8];
            CvtTile cur = cvt_decode(it < CVT_NTILES ? it : 0, w_in, w_out, WIN, WOUT);
            if (it < CVT_NTILES) {
#pragma unroll
                for (int j = 0; j < 8; ++j) v[j] = __builtin_nontemporal_load((const f32x4*)(cur.src + (size_t)(8 * wave + j) * cur.ldw) + lane);
            }
            int buf = 0;
            while (it < CVT_NTILES) {
                LAS unsigned char* tb = lds + buf * 32768;
                u32x4 p[4];
#pragma unroll
                for (int c = 0; c < 4; ++c) { p[c].x = cvt_pk_bf16(v[0][c], v[1][c]); p[c].y = cvt_pk_bf16(v[2][c], v[3][c]); p[c].z = cvt_pk_bf16(v[4][c], v[5][c]); p[c].w = cvt_pk_bf16(v[6][c], v[7][c]); }
#pragma unroll
                for (int c = 0; c < 4; ++c) { const int r = 4 * lane + c; *(LAS u32x4*)(tb + r * 128 + ((wave ^ swz_f(r)) << 4)) = p[c]; }
                const int nit = it + G; const bool has_next = nit < CVT_NTILES;
                CvtTile nx = cvt_decode(has_next ? nit : 0, w_in, w_out, WIN, WOUT);
                if (has_next) {
#pragma unroll
                    for (int j = 0; j < 8; ++j) v[j] = __builtin_nontemporal_load((const f32x4*)(nx.src + (size_t)(8 * wave + j) * nx.ldw) + lane);
                }
                __syncthreads();
#pragma unroll
                for (int i = 0; i < 4; ++i) { const int r = (tid >> 3) + 64 * i, ch = tid & 7; const u32x4 o = *(const LAS u32x4*)(tb + r * 128 + ((ch ^ swz_f(r)) << 4));
                    *(u32x4*)(cur.dst + (size_t)(cur.n0 + r) * cur.ldt + 8 * ch) = o; }
                buf ^= 1; it = nit; cur = nx;
            }
            __syncthreads();
        }
        for (int i = bx * NTHREADS + tid; i < 4 * 65536; i += G * NTHREADS) { const int g = i >> 16, d = i & 255; WPOOL[i] = (bf16_t)f2bf(w_pool[i] * pool_scale[g * 256 + d]); }
        for (int i = bx * NTHREADS + tid; i < 48 * D; i += G * NTHREADS) { const int c = i / D, k = i % D; const float w = c < 4 ? w_rg[k * 4 + c] * g2[k] : (c < NRC ? w_re[k * 32 + (c - 4)] * g2[k] : 0.f);
            const unsigned hi = f2bf(w); const float wl = w - __builtin_bit_cast(float, hi << 16); WRTH[i] = (bf16_t)hi; WRTL[i] = (bf16_t)f2bf(wl); }
        for (int m = gw; m < T; m += NGW) {
            const f32x4* xr = (const f32x4*)(x + (size_t)m * D) + lane; f32x4 v[8]; float s = 0.f;
#pragma unroll
            for (int j = 0; j < 8; ++j) { v[j] = xr[64 * j]; s += (v[j].x * v[j].x + v[j].y * v[j].y) + (v[j].z * v[j].z + v[j].w * v[j].w); }
            const float rstd = 1.0f / sqrtf(wave_sum(s) * (1.0f / D) + EPS);
            u32x2* o = (u32x2*)(XN + (size_t)m * D) + lane;
#pragma unroll
            for (int j = 0; j < 8; ++j) { const f32x4 g = ((const f32x4*)g1)[64 * j + lane]; u32x2 w; w.x = pk2(v[j].x * rstd * g.x, v[j].y * rstd * g.y); w.y = pk2(v[j].z * rstd * g.z, v[j].w * rstd * g.w); o[64 * j] = w; }
        }
    }
    xcd_barrier(bar);
    }

    for (int rep_ = 0; rep_ < REP_P1; ++rep_) {
    {
        ProbDense P{XN, WIN, D, D, D, T / 256, INC / 256, G, bx};
        EpiBf16 E{PROJ, INC, nullptr, 0};
        pg8::gemm_phase<ProbDense, EpiBf16, true>(lds, P, E);
    }
    xcd_barrier(bar);
    }

    for (int rep_ = 0; rep_ < REP_P2; ++rep_) {
    {
        if (rep_ == 0) { ProbWeff P{WOUT, WPOOL, 256, D, 256, G, vcu}; EpiBf16 E{WOUT, D, nullptr, 1}; pg8::gemm_phase<ProbWeff, EpiBf16, false>(lds, P, E); }
        bf16_t* const POOLDST = MIXED; constexpr int POOLLD = D;
        for (int it = gw; it < 2048; it += NGW) {
            const int part = it >> 10, q = it & 1023, chunk = q >> 1, slab = q & 1, r0 = chunk * 16, c0 = slab * 512 + lane * 8;
#define BF8(v, f) { f[0] = bflo(v.x); f[1] = bfhi(v.x); f[2] = bflo(v.y); f[3] = bfhi(v.y); f[4] = bflo(v.z); f[5] = bfhi(v.z); f[6] = bflo(v.w); f[7] = bfhi(v.w); }
            if (part == 0) {
                const int gi = c0 >> 8, w = 2 << gi;
                float s[8];
#pragma unroll
                for (int j = 0; j < 8; ++j) s[j] = 0.f;
                { u32x4 iv[16];
#pragma unroll
                  for (int i = 0; i < 16; ++i) { const int rr = r0 - 1 - i; iv[i] = *(const u32x4*)(PROJ + (size_t)(rr < 0 ? 0 : rr) * INC + c0); }
#pragma unroll
                  for (int i = 0; i < 16; ++i) { const bool ok = (i < w) && (r0 - 1 - i >= 0); float f[8]; BF8(iv[i], f);
#pragma unroll
                      for (int j = 0; j < 8; ++j) s[j] += ok ? f[j] : 0.f; } }
#pragma unroll 1
                for (int tb = 0; tb < 2; ++tb) {
                    const int t0 = r0 + 8 * tb; u32x4 nv[8], ov[8];
#pragma unroll
                    for (int k = 0; k < 8; ++k) { nv[k] = *(const u32x4*)(PROJ + (size_t)(t0 + k) * INC + c0); const int ro = t0 + k - w; ov[k] = *(const u32x4*)(PROJ + (size_t)(ro < 0 ? 0 : ro) * INC + c0); }
#pragma unroll
                    for (int k = 0; k < 8; ++k) { const int t = t0 + k; float un[8], uo[8]; BF8(nv[k], un); BF8(ov[k], uo); const bool ok = t - w >= 0;
#pragma unroll
                        for (int j = 0; j < 8; ++j) s[j] += un[j] - (ok ? uo[j] : 0.f);
                        const int cn = (t + 1) < w ? (t + 1) : w; const float inv = 1.0f / (float)cn;
                        u32x4 p; p.x = pk2(s[0] * inv - un[0], s[1] * inv - un[1]); p.y = pk2(s[2] * inv - un[2], s[3] * inv - un[3]);
                        p.z = pk2(s[4] * inv - un[4], s[5] * inv - un[5]); p.w = pk2(s[6] * inv - un[6], s[7] * inv - un[7]);
                        *(u32x4*)(POOLDST + (size_t)t * POOLLD + c0) = p; }
                }
            } else {
                float cw[8][3];
#pragma unroll
                for (int j = 0; j < 8; ++j) { cw[j][0] = conv_w[(c0 + j) * 3 + 0]; cw[j][1] = conv_w[(c0 + j) * 3 + 1]; cw[j][2] = conv_w[(c0 + j) * 3 + 2]; }
                float z2[8], z1[8];
                { const int ra = r0 >= 2 ? r0 - 2 : 0, rb = r0 >= 1 ? r0 - 1 : 0;
                  const u32x4 ca = *(const u32x4*)(PROJ + (size_t)ra * INC + MIXA + MIXB + c0), va = *(const u32x4*)(PROJ + (size_t)ra * INC + MIXA + 2 * MIXB + c0);
                  const u32x4 cb = *(const u32x4*)(PROJ + (size_t)rb * INC + MIXA + MIXB + c0), vb = *(const u32x4*)(PROJ + (size_t)rb * INC + MIXA + 2 * MIXB + c0);
                  float fa[8], fb[8], fc[8], fd[8]; BF8(ca, fa); BF8(va, fb); BF8(cb, fc); BF8(vb, fd);
#pragma unroll
                  for (int j = 0; j < 8; ++j) { z2[j] = r0 >= 2 ? fa[j] * fb[j] : 0.f; z1[j] = r0 >= 1 ? fc[j] * fd[j] : 0.f; } }
#pragma unroll 1
                for (int tb = 0; tb < 2; ++tb) {
                    const int t0 = r0 + 8 * tb; u32x4 bbv[8], ccv[8], vvv[8];
#pragma unroll
                    for (int k = 0; k < 8; ++k) { const bf16_t* pr = PROJ + (size_t)(t0 + k) * INC + c0; bbv[k] = *(const u32x4*)(pr + MIXA); ccv[k] = *(const u32x4*)(pr + MIXA + MIXB); vvv[k] = *(const u32x4*)(pr + MIXA + 2 * MIXB); }
#pragma unroll
                    for (int k = 0; k < 8; ++k) { float bg[8], cg[8], vg[8]; BF8(bbv[k], bg); BF8(ccv[k], cg); BF8(vvv[k], vg); float yv[8];
#pragma unroll
                        for (int j = 0; j < 8; ++j) { const float z0 = cg[j] * vg[j]; yv[j] = bg[j] * (z2[j] * cw[j][0] + z1[j] * cw[j][1] + z0 * cw[j][2]); z2[j] = z1[j]; z1[j] = z0; }
                        u32x4 p; p.x = pk2(yv[0], yv[1]); p.y = pk2(yv[2], yv[3]); p.z = pk2(yv[4], yv[5]); p.w = pk2(yv[6], yv[7]);
                        *(u32x4*)(MIXED + (size_t)(t0 + k) * D + MIXA + c0) = p; }
                }
            }
#undef BF8
        }
    }
    xcd_barrier(bar);
    }

    for (int rep_ = 0; rep_ < REP_P4; ++rep_) {
    {
        ProbDense P{MIXED, WOUT, D, D, D, T / 256, D / 256, G, bx};
        EpiBf16 E{MIXO, D, nullptr, 0};
        pg8::gemm_phase<ProbDense, EpiBf16, false>(lds, P, E);
    }
    xcd_barrier(bar);
    }

    for (int rep_ = 0; rep_ < REP_P5; ++rep_) {
    {
        bf16_t* H2 = XN;
        for (int rb = vcu; rb < T / 32; rb += G) {
            const int row0 = rb * 32 + wave * 4;
            float rstd[4]; float mylog[4];
            {
                LAS float* red = (LAS float*)lds;
                LAS float* ssp = red + 8 * 6 * 64 * 4;
                LAS float* lgs = ssp + 8 * 2 * 64;
                LAS float* rsd = lgs + 32 * 48;
                const int rowb = rb * 32, fr = lane & 15, fq = lane >> 4;
                f32x4 acc[2][3];
#pragma unroll
                for (int a = 0; a < 2; ++a)
#pragma unroll
                    for (int c = 0; c < 3; ++c) acc[a][c] = (f32x4){0.f, 0.f, 0.f, 0.f};
                float ssl[2] = {0.f, 0.f};
#pragma unroll 2
                for (int ks = 0; ks < 8; ++ks) {
                    const int k0 = 256 * wave + 32 * ks + 8 * fq;
                    bf16x8 bh[3], bl[3];
#pragma unroll
                    for (int c = 0; c < 3; ++c) { bh[c] = *(const bf16x8*)(WRTH + (size_t)(16 * c + fr) * D + k0); bl[c] = *(const bf16x8*)(WRTL + (size_t)(16 * c + fr) * D + k0); }
#pragma unroll
                    for (int a = 0; a < 2; ++a) { const size_t ro = (size_t)(rowb + 16 * a + fr) * D + k0;
                        const f32x4 xa = *(const f32x4*)(x + ro), xb = *(const f32x4*)(x + ro + 4); const u32x4 mo = *(const u32x4*)(MIXO + ro);
                        const float v[8] = {xa.x + bflo(mo.x), xa.y + bfhi(mo.x), xa.z + bflo(mo.y), xa.w + bfhi(mo.y), xb.x + bflo(mo.z), xb.y + bfhi(mo.z), xb.z + bflo(mo.w), xb.w + bfhi(mo.w)};
                        u32x4 hp, lp;
#pragma unroll
                        for (int q = 0; q < 4; ++q) { const unsigned h = cvt_pk_bf16(v[2 * q], v[2 * q + 1]); hp[q] = h; lp[q] = cvt_pk_bf16(v[2 * q] - bflo(h), v[2 * q + 1] - bfhi(h));
                            ssl[a] += v[2 * q] * v[2 * q] + v[2 * q + 1] * v[2 * q + 1]; }
                        const bf16x8 ah = __builtin_bit_cast(bf16x8, hp), al = __builtin_bit_cast(bf16x8, lp);
#pragma unroll
                        for (int c = 0; c < 3; ++c) { acc[a][c] = __builtin_amdgcn_mfma_f32_16x16x32_bf16(ah, bh[c], acc[a][c], 0, 0, 0); acc[a][c] = __builtin_amdgcn_mfma_f32_16x16x32_bf16(ah, bl[c], acc[a][c], 0, 0, 0);
                            acc[a][c] = __builtin_amdgcn_mfma_f32_16x16x32_bf16(al, bh[c], acc[a][c], 0, 0, 0); } }
                }
#pragma unroll
                for (int a = 0; a < 2; ++a) { ssp[(wave * 2 + a) * 64 + lane] = ssl[a];
#pragma unroll
                    for (int c = 0; c < 3; ++c) *(LAS f32x4*)(red + ((wave * 6 + a * 3 + c) * 64 + lane) * 4) = acc[a][c]; }
                __syncthreads();
#pragma unroll
                for (int i = 0; i < 3; ++i) { const int o = tid + 512 * i, r = o / 48, c = o - 48 * r, a = r >> 4, rr = r & 15, cb = c >> 4, cc = c & 15, ln = cc + 16 * (rr >> 2), reg = rr & 3; float s = 0.f;
#pragma unroll
                    for (int w = 0; w < 8; ++w) s += red[((w * 6 + a * 3 + cb) * 64 + ln) * 4 + reg];
                    lgs[o] = s; }
                if (tid < 32) { const int a = tid >> 4, rr = tid & 15; float s = 0.f;
#pragma unroll
                    for (int w = 0; w < 8; ++w)
#pragma unroll
                        for (int q = 0; q < 4; ++q) s += ssp[(w * 2 + a) * 64 + rr + 16 * q];
                    rsd[tid] = 1.0f / sqrtf(s * (1.0f / D) + EPS); }
                __syncthreads();
#pragma unroll
                for (int r = 0; r < 4; ++r) { rstd[r] = rsd[4 * wave + r]; mylog[r] = (lane < 48 ? lgs[(4 * wave + r) * 48 + lane] : 0.f) * rstd[r]; }
            }
#pragma unroll
            for (int j = 0; j < 8; ++j) { const f32x4 g = ((const f32x4*)g2)[64 * j + lane];
#pragma unroll
                for (int r = 0; r < 4; ++r) { const u32x2 mo = *((const u32x2*)(MIXO + (size_t)(row0 + r) * D + 256 * j) + lane); f32x4 xv = *((const f32x4*)(x + (size_t)(row0 + r) * D + 256 * j) + lane);
                    xv.x += bflo(mo.x); xv.y += bfhi(mo.x); xv.z += bflo(mo.y); xv.w += bfhi(mo.y);
                    const float sc = rstd[r] * tt8::SC_A;
                    ((unsigned*)((unsigned char*)H2 + (size_t)(row0 + r) * D))[64 * j + lane] = tt8::pack4_fp8(xv.x * sc * g.x, xv.y * sc * g.y, xv.z * sc * g.z, xv.w * sc * g.w);
                } }
            const float bias = lane < 4 ? b_rg[lane] : (lane < NRC ? b_re[lane - 4] : 0.f);
#pragma unroll
            for (int r = 0; r < 4; ++r) {
                const float lg = mylog[r] + bias;
                float g[4];
#pragma unroll
                for (int i = 0; i < 4; ++i) g[i] = __shfl(lg, i);
                int grp = 0; float gm = g[0];
#pragma unroll
                for (int i = 1; i < 4; ++i) if (g[i] > gm) { gm = g[i]; grp = i; }
                float gs = 0.f;
#pragma unroll
                for (int i = 0; i < 4; ++i) gs += expf(g[i] - gm);
                const float g_w = 1.0f / gs;
                float el[8];
#pragma unroll
                for (int i = 0; i < 8; ++i) el[i] = __shfl(lg, 4 + grp * 8 + i);
                int i0 = 0; float m0 = el[0];
#pragma unroll
                for (int i = 1; i < 8; ++i) if (el[i] > m0) { m0 = el[i]; i0 = i; }
                int i1 = -1; float m1 = -3.0e38f;
#pragma unroll
                for (int i = 0; i < 8; ++i) if (i != i0 && el[i] > m1) { m1 = el[i]; i1 = i; }
                const float p1 = expf(m1 - m0);
                const float w0 = g_w / (1.0f + p1), w1 = g_w * p1 / (1.0f + p1);
                if (lane == 0) { const int a = (wave * 4 + r) * 2; misc[256 + a] = grp * 8 + i0; misc[256 + a + 1] = grp * 8 + i1;
                    misc[384 + a] = __builtin_bit_cast(int, w0); misc[384 + a + 1] = __builtin_bit_cast(int, w1); }
            }
            __syncthreads();
            if (wave == 0) {
                const int a = lane, tok = rb * 32 + (a >> 1), e = misc[256 + a];
                unsigned long long mym = 0ull;
#pragma unroll 1
                for (int ee = 0; ee < NE; ++ee) { const unsigned long long m = __ballot(e == ee); if (e == ee) mym = m; }
                const int rank = __popcll(mym & ((1ull << lane) - 1ull)), cntl = __popcll(mym), leader = __ffsll((long long)mym) - 1;
                int base = 0;
                if (rank == 0) base = (int)__hip_atomic_fetch_add(ctl + CW_ECNT + 64 * e + (rep_ == REP_P5 - 1 ? 0 : 32), (unsigned)cntl, RLX_AGENT);
                base = __shfl(base, leader);
                const int pos = base + rank;
                LIST[(size_t)e * T + pos] = tok;
                ((int*)ASG)[(size_t)tok * 4 + (a & 1) * 2] = e; ((int*)ASG)[(size_t)tok * 4 + (a & 1) * 2 + 1] = pos;
                ((int*)ASW)[(size_t)tok * 2 + (a & 1)] = misc[384 + a];
            }
            __syncthreads();
        }
    }
    xcd_barrier(bar);
    }

    for (int rep_ = 0; rep_ < REP_P67; ++rep_) {
    {
        const int nu = build_tt_units(misc, ctl, vcu, G);
        ProbTT8a P{(const unsigned char*)XN, w_gate, w_up, LIST, D, D, DE, misc + MISC_NUNIT + 8, nu};
        EpiTT8Swiglu E{(unsigned char*)HID, DE};
        for (int r6_ = 0; r6_ < REP_P6; ++r6_) { if (r6_) xcd_barrier(bar); tt8::gemm_phase<ProbTT8a, EpiTT8Swiglu>(lds, P, E); }
    }
    xcd_barrier(bar);

    {
        const int nu = build_tt_units(misc, ctl, vcu, G);
        ProbTT8b P{(const unsigned char*)HID, w_down, DE, DE, D, misc + MISC_NUNIT + 8, nu};
        EpiTT8Y E{Y, D};
        for (int r7_ = 0; r7_ < REP_P7; ++r7_) { if (r7_) xcd_barrier(bar); tt8::gemm_phase<ProbTT8b, EpiTT8Y>(lds, P, E); }
    }
    xcd_barrier(bar);

    }
    for (int rep_ = 0; rep_ < REP_P8; ++rep_) {
    if (rep_) xcd_barrier(bar);
    {
        volatile LAS int* pst = misc + MISC_ETAB + 64;
        for (int m = gw; m < T; m += NGW) {
            const i32x4 as = ASG[m]; const f32x2 aw = ASW[m];
            const int s0 = pst[as.x] + as.y, s1 = pst[as.z] + as.w;
            const f32x4* xr = (const f32x4*)(x + (size_t)m * D) + lane; const u32x2* mo_ = (const u32x2*)(MIXO + (size_t)m * D) + lane; const u32x2* y0 = (const u32x2*)(Y + (size_t)s0 * D) + lane; const u32x2* y1 = (const u32x2*)(Y + (size_t)s1 * D) + lane;
            f32x4 v[8]; float s = 0.f;
#pragma unroll
            for (int j = 0; j < 8; ++j) { f32x4 xx = xr[64 * j]; const u32x2 a = y0[64 * j], b = y1[64 * j], mo = mo_[64 * j];
                xx.x += bflo(mo.x); xx.y += bfhi(mo.x); xx.z += bflo(mo.y); xx.w += bfhi(mo.y);
                v[j].x = xx.x + aw.x * bflo(a.x) + aw.y * bflo(b.x); v[j].y = xx.y + aw.x * bfhi(a.x) + aw.y * bfhi(b.x);
                v[j].z = xx.z + aw.x * bflo(a.y) + aw.y * bflo(b.y); v[j].w = xx.w + aw.x * bfhi(a.y) + aw.y * bfhi(b.y);
                s += (v[j].x * v[j].x + v[j].y * v[j].y) + (v[j].z * v[j].z + v[j].w * v[j].w); }
            const float rstd = 1.0f / sqrtf(wave_sum(s) * (1.0f / D) + EPS);
            f32x4* o = (f32x4*)(out + (size_t)m * D) + lane;
#pragma unroll
            for (int j = 0; j < 8; ++j) { const f32x4 g = ((const f32x4*)g3)[64 * j + lane]; o[64 * j] = (f32x4){v[j].x * rstd * g.x, v[j].y * rstd * g.y, v[j].z * rstd * g.z, v[j].w * rstd * g.w}; }
        }
    }
    }
}

extern "C" void kernel_launch(void* const* d_in, const int* in_sizes, int n_in, void* d_out, int out_size, void* d_ws, size_t ws_size, hipStream_t stream) {
    static int grid = 0;
    if (grid == 0) {
        if (n_in != 16 || in_sizes[0] != T * D || out_size != T * D || ws_size < WS_END) { fprintf(stderr, "kernel_launch: unexpected shapes (n_in %d, in0 %d, out %d, ws %zu); nothing launched\n", n_in, n_in > 0 ? in_sizes[0] : -1, out_size, ws_size); grid = -1; return; }
        int dev = 0, cus = 0, per_cu = 0;
        if (hipGetDevice(&dev) != hipSuccess || hipDeviceGetAttribute(&cus, hipDeviceAttributeMultiprocessorCount, dev) != hipSuccess) { fprintf(stderr, "kernel_launch: device query failed\n"); grid = -1; return; }
        if (hipFuncSetAttribute((const void*)fwd_kernel, hipFuncAttributeMaxDynamicSharedMemorySize, LDS_BYTES) != hipSuccess) { fprintf(stderr, "kernel_launch: hipFuncSetAttribute failed\n"); grid = -1; return; }
        if (hipOccupancyMaxActiveBlocksPerMultiprocessor(&per_cu, (const void*)fwd_kernel, NTHREADS, LDS_BYTES) != hipSuccess || per_cu < 1) { fprintf(stderr, "kernel_launch: occupancy query says %d blocks per CU; nothing launched\n", per_cu); (void)hipGetLastError(); grid = -1; return; }
        grid = cus;
    }
    if (grid < 0) return;
    if (hipMemsetAsync((char*)d_ws + WS_CTL, 0, CTL_BYTES, stream) != hipSuccess) { fprintf(stderr, "kernel_launch: memset failed\n"); return; }
    Args a{};
    for (int i = 0; i < 16; ++i) a.in[i] = (const float*)d_in[i];
    a.out = (float*)d_out; a.ws = (unsigned char*)d_ws;
    void* kargs[] = {&a};
    hipError_t le = hipLaunchCooperativeKernel((const void*)fwd_kernel, dim3(grid), dim3(NTHREADS), kargs, LDS_BYTES, stream);
    if (le != hipSuccess) fprintf(stderr, "kernel_launch: cooperative launch failed: %s (grid %d)\n", hipGetErrorString(le), grid);
}
```

```cpp
#include <hip/hip_runtime.h>
#include <cstdio>
#include <cstdint>

#define LAS __attribute__((address_space(3)))
#define GAS __attribute__((address_space(1)))
typedef unsigned short bf16_t;
typedef short bf16x8 __attribute__((ext_vector_type(8)));
typedef float f32x4 __attribute__((ext_vector_type(4)));
typedef float f32x2 __attribute__((ext_vector_type(2)));
typedef unsigned u32x4 __attribute__((ext_vector_type(4)));
typedef unsigned u32x2 __attribute__((ext_vector_type(2)));
typedef int i32x4 __attribute__((ext_vector_type(4)));

#ifndef REP_P0
#define REP_P0 1
#endif
#ifndef REP_P1
#define REP_P1 1
#endif
#ifndef REP_P2
#define REP_P2 1
#endif
#ifndef REP_P3
#define REP_P3 1
#endif
#ifndef REP_P4
#define REP_P4 1
#endif
#ifndef REP_P5
#define REP_P5 1
#endif
#ifndef REP_P6
#define REP_P6 1
#endif
#ifndef REP_P7
#define REP_P7 1
#endif
#ifndef REP_P67
#define REP_P67 1
#endif
#ifndef REP_P8
#define REP_P8 1
#endif
constexpr int T = 8192, D = 2048, INC = 4096, MIXA = 1024, MIXB = 1024, NE = 32, DE = 1024, NGRP = 4, EPG = 8;
constexpr int POOLCH = 256, NRC = 36;
constexpr float EPS = 1e-6f;
constexpr int MAXSLOT = 24576;
constexpr int NWAVES = 8, NTHREADS = 512;

constexpr size_t MiB = 1u << 20;
constexpr size_t WS_CTL = 0, CTL_BYTES = 64 * 1024;
constexpr size_t WS_WRT = 1 * MiB;
constexpr size_t WS_WPOOL = 2 * MiB;
constexpr size_t WS_LIST = 3 * MiB;
constexpr size_t WS_ASG = 4 * MiB;
constexpr size_t WS_ASW = 5 * MiB;
constexpr size_t WS_WIN = 8 * MiB;
constexpr size_t WS_WOUT = 24 * MiB;
constexpr size_t WS_XN = 32 * MiB;
constexpr size_t WS_PROJ = 64 * MiB;
constexpr size_t WS_MIXED = 144 * MiB;
constexpr size_t WS_X1 = 176 * MiB;
constexpr size_t WS_HID = 240 * MiB;
constexpr size_t WS_Y = 288 * MiB;
constexpr size_t WS_END = 384 * MiB;
constexpr int CW_ECNT = 1024;
constexpr int CW_BAR = 4096;

constexpr int RING_BYTES = 135168;
constexpr int MISC_OFF = RING_BYTES;
constexpr int MISC_BAR = 0;
constexpr int MISC_ETAB = 16;
constexpr int MISC_NUNIT = 160;
constexpr int LDS_BYTES = 147456;

#define LDS_WAIT() asm volatile("s_waitcnt lgkmcnt(0)" ::: "memory")
#define VM_WAIT() asm volatile("s_waitcnt vmcnt(0)" ::: "memory")
#define RLX_AGENT __ATOMIC_RELAXED, __HIP_MEMORY_SCOPE_AGENT

__device__ __forceinline__ unsigned f2bf(float f) { unsigned u = __builtin_bit_cast(unsigned, f); return (u + 0x7fffu + ((u >> 16) & 1u)) >> 16; }
__device__ __forceinline__ unsigned pk2(float lo, float hi) { return f2bf(lo) | (f2bf(hi) << 16); }
__device__ __forceinline__ unsigned cvt_pk_bf16(float lo, float hi) { unsigned r; asm volatile("v_cvt_pk_bf16_f32 %0, %1, %2" : "=v"(r) : "v"(lo), "v"(hi)); return r; }
__device__ __forceinline__ float bflo(unsigned w) { return __builtin_bit_cast(float, w << 16); }
__device__ __forceinline__ float bfhi(unsigned w) { return __builtin_bit_cast(float, w & 0xffff0000u); }
__device__ __forceinline__ float wave_sum(float v) {
#pragma unroll
    for (int o = 1; o < 64; o <<= 1) v += __shfl_xor(v, o);
    return v;
}

__device__ __forceinline__ float wave_sum_dpp(float v) {
    v += __builtin_bit_cast(float, __builtin_amdgcn_update_dpp(0, __builtin_bit_cast(int, v), 0xB1, 0xF, 0xF, false));
    v += __builtin_bit_cast(float, __builtin_amdgcn_update_dpp(0, __builtin_bit_cast(int, v), 0x4E, 0xF, 0xF, false));
    v += __builtin_bit_cast(float, __builtin_amdgcn_update_dpp(0, __builtin_bit_cast(int, v), 0x141, 0xF, 0xF, false));
    v += __builtin_bit_cast(float, __builtin_amdgcn_update_dpp(0, __builtin_bit_cast(int, v), 0x140, 0xF, 0xF, false));
    v += __builtin_bit_cast(float, __builtin_amdgcn_update_dpp(0, __builtin_bit_cast(int, v), 0x142, 0xA, 0xF, false));
    v += __builtin_bit_cast(float, __builtin_amdgcn_update_dpp(0, __builtin_bit_cast(int, v), 0x143, 0xC, 0xF, false));
    return __builtin_bit_cast(float, __builtin_amdgcn_readlane(__builtin_bit_cast(int, v), 63));
}

#define XB_TMO      128
#define XB_XCNT(j)  (256  + 64 * (j))
#define XB_XSUB(j)  (1280 + 64 * (j))
#define XB_XGEN(j)  (2304 + 64 * (j))
#define XB_TOP      3328
#define XB_TOPGEN   3392
#define XCD_BAR_WORDS 3456
#define XB_SPIN_CAP (1u << 18)
__device__ __forceinline__ unsigned xb_ld(unsigned* p)              { return __hip_atomic_load(p, __ATOMIC_RELAXED, __HIP_MEMORY_SCOPE_AGENT); }
__device__ __forceinline__ unsigned xb_add(unsigned* p, unsigned v) { return __hip_atomic_fetch_add(p, v, __ATOMIC_RELAXED, __HIP_MEMORY_SCOPE_AGENT); }
__device__ __forceinline__ unsigned xb_xcc_id() { return (unsigned)__builtin_amdgcn_s_getreg((3 << 11) | 20) & 0xFu; }
#define XB_SPIN(cond, bar) do { unsigned _sp = 0; while (cond) { __builtin_amdgcn_s_sleep(1); \
    if ((++_sp & 255u) == 0u) { if (xb_ld(&(bar)[XB_TMO])) break; if (_sp > XB_SPIN_CAP) { atomicAdd(&(bar)[XB_TMO], 1u); break; } } } } while (0)
struct XcdBarrier { unsigned* bar; unsigned x; volatile LAS unsigned* st; };
__device__ __forceinline__ XcdBarrier xcd_barrier_post(unsigned* bar, volatile LAS unsigned* st) {
    XcdBarrier b; b.bar = bar; b.x = xb_xcc_id(); b.st = st;
    if (threadIdx.x == 0) (void)xb_add(&bar[XB_XCNT(b.x)], 1u);
    return b;
}
__device__ __forceinline__ void xcd_barrier_complete(unsigned* bar, unsigned x, unsigned& nloc, unsigned& nx) {
    const unsigned G = gridDim.x * gridDim.y * gridDim.z;
    unsigned sum, cnt, mine, sp = 0u;
    for (;;) {
        sum = 0u; cnt = 0u; mine = 0u;
#pragma unroll
        for (unsigned j = 0; j < 16; ++j) { const unsigned c = xb_ld(&bar[XB_XCNT(j)]); sum += c; cnt += (c > 0u) ? 1u : 0u; mine = (j == x) ? c : mine; }
        if (sum == G) break;
        __builtin_amdgcn_s_sleep(1);
        if ((++sp & 255u) == 0u) { if (xb_ld(&bar[XB_TMO])) break; if (sp > XB_SPIN_CAP) { atomicAdd(&bar[XB_TMO], 1u); break; } }
    }
    nloc = mine > 0u ? mine : 1u; nx = cnt > 0u ? cnt : 1u;
}
__device__ __forceinline__ void xcd_barrier(const XcdBarrier& b) {
    asm volatile("s_waitcnt vmcnt(0)" ::: "memory");
    __syncthreads();
    if (threadIdx.x == 0) {
        unsigned* bar = b.bar;
        __builtin_amdgcn_s_waitcnt(0);
        unsigned nloc = b.st[0], nx = b.st[1];
        if (nloc == 0u) { xcd_barrier_complete(bar, b.x, nloc, nx); b.st[0] = nloc; b.st[1] = nx; }
        const unsigned old = xb_add(&bar[XB_XSUB(b.x)], 1u);
        const unsigned gen = old / nloc;
        if (old + 1u == (gen + 1u) * nloc) {
            __builtin_amdgcn_fence(__ATOMIC_RELEASE, "agent");
            asm volatile("s_waitcnt vmcnt(0)" ::: "memory");
            const unsigned og = xb_add(&bar[XB_TOP], 1u);
            const unsigned tg = og / nx;
            if (og + 1u == (tg + 1u) * nx) xb_add(&bar[XB_TOPGEN], 1u);
            else XB_SPIN(xb_ld(&bar[XB_TOPGEN]) == tg, bar);
            __builtin_amdgcn_fence(__ATOMIC_ACQUIRE, "agent");
            asm volatile("s_waitcnt vmcnt(0)" ::: "memory");
        } else {
            XB_SPIN(xb_ld(&bar[XB_TOPGEN]) == gen, bar);
            __builtin_amdgcn_fence(__ATOMIC_ACQUIRE, "agent");
            asm volatile("s_waitcnt vmcnt(0)" ::: "memory");
        }
    }
    __syncthreads();
}

namespace pg8 {
constexpr int BM = 256, BK = 64, HALF = 128, HTB = HALF * BK * 2, NXCD = 8, WGM = 8;
__host__ __device__ __forceinline__ int lds_byte(int r, int c) { const int st = (r >> 4) * 2 + (c >> 5), rr = r & 15, cc = c & 31, ob = rr * 64 + cc * 2; return st * 1024 + (ob ^ (((ob >> 9) & 1) << 5)); }
__host__ __device__ __forceinline__ void stage_rc(int b, int& R, int& C) { const int st = b / 1024, sb = b % 1024, swz = sb ^ (((sb >> 9) & 1) << 5); R = (st >> 1) * 16 + swz / 64; C = (st & 1) * 32 + (swz % 64) / 2; }
__host__ __device__ __forceinline__ int perm32(int rho) { const int n = rho >> 4, i = rho & 15; return 8 * (i >> 2) + 4 * n + (i & 3); }

struct Unit { int e, pm, pn, row0, nvalid, p0, p1, self; };

__device__ __forceinline__ bool static_order(int nM, int nN, int G, int c, int i, int& pm, int& pn) {
    const int nwg = nM * nN; const long L = (long)i * G + c; if (L >= nwg) return false;
    int wgid = (int)L; { const int q = nwg / NXCD, r = nwg % NXCD, xcd = wgid % NXCD, off = wgid / NXCD; wgid = (xcd < r ? xcd * (q + 1) : r * (q + 1) + (xcd - r) * q) + off; }
    const int nig = WGM * nN, gid = wgid / nig, fm = gid * WGM, gsz = (nM - fm) < WGM ? (nM - fm) : WGM;
    pm = fm + ((wgid % nig) % gsz); pn = (wgid % nig) / gsz; return true;
}

template <class Prob, class Epi, bool ALIGN_EPI>
__device__ __forceinline__ void gemm_phase(LAS unsigned char* lds, const Prob& P, const Epi& E) {
    int tid_ = threadIdx.x; asm volatile("" : "+v"(tid_));
    const int tid = tid_, wid = __builtin_amdgcn_readfirstlane(tid >> 6), lane = tid & 63, wr = wid >> 2, wc = wid & 3, fr = lane & 15, fq = lane >> 4;
    const int K = P.K, nt = K / BK;
    int Rr[2], Cc[2];
    unsigned voffA[2][2], voffB[2], nvoffA[2][2];
#pragma unroll
    for (int i = 0; i < 2; ++i) { stage_rc(tid * 16 + i * 8192, Rr[i], Cc[i]); const int Rb = Epi::PERM ? ((Rr[i] & ~31) + perm32(Rr[i] & 31)) : Rr[i];
        voffB[i] = (unsigned)(Rb * P.ldb + Cc[i]) * 2u;
        voffA[0][i] = (unsigned)(Rr[i] * P.lda + Cc[i]) * 2u; voffA[1][i] = (unsigned)((Rr[i] + HALF) * P.lda + Cc[i]) * 2u; }
    const size_t kstep = (size_t)(BK * 2);
    const size_t hstepB = (size_t)HALF * P.ldb * 2;
    const unsigned ldsw = (unsigned)wid * 1024u;
    const int aoff = lds_byte(wr * 64 + fr, fq * 8), boff = lds_byte(wc * 32 + fr, fq * 8);
#define PG8_SA(b, h) (((b) * 2 + (h)) * HTB)
#define PG8_SB(b, h) ((4 + (b) * 2 + (h)) * HTB)
#define PG8_STAGE(bufoff, gbase, voff) do { _Pragma("unroll") for (int _i = 0; _i < 2; ++_i) \
        __builtin_amdgcn_global_load_lds((const unsigned*)((const char*)(gbase) + (voff)[_i]), (LAS unsigned*)(lds + (bufoff) + ldsw + _i * 8192), 16, 0, 0); } while (0)
#define PG8_LDA(dst, b, h) do { _Pragma("unroll") for (int m = 0; m < 4; ++m) _Pragma("unroll") for (int k = 0; k < 2; ++k) dst[m][k] = *(const LAS bf16x8*)(lds + PG8_SA(b, h) + aoff + m * 2048 + k * 1024); } while (0)
#define PG8_LDB(dst, b, h) do { _Pragma("unroll") for (int n = 0; n < 2; ++n) _Pragma("unroll") for (int k = 0; k < 2; ++k) dst[n][k] = *(const LAS bf16x8*)(lds + PG8_SB(b, h) + boff + n * 2048 + k * 1024); } while (0)
#define PG8_MMA(ai, bj, At, Bt) do { __builtin_amdgcn_s_setprio(1); _Pragma("unroll") for (int m = 0; m < 4; ++m) _Pragma("unroll") for (int n = 0; n < 2; ++n) _Pragma("unroll") for (int k = 0; k < 2; ++k) \
        acc[ai][bj][m][n] = __builtin_amdgcn_mfma_f32_16x16x32_bf16(Bt[n][k], At[m][k], acc[ai][bj][m][n], 0, 0, 0); __builtin_amdgcn_s_setprio(0); } while (0)
#define PG8_WAIT_V(n) asm volatile("s_waitcnt vmcnt(" #n ")" ::: "memory")
#define PG8_WAIT_L(n) asm volatile("s_waitcnt lgkmcnt(" #n ")" ::: "memory")
#define PG8_BAR __builtin_amdgcn_s_barrier()
#define PG8_SCHED __builtin_amdgcn_sched_barrier(0)
    Unit cur, nxt; int ui = 0;
    if (!P.next(0, cur)) return;
    f32x4 acc[2][2][4][2];
#pragma unroll
    for (int a = 0; a < 2; ++a)
#pragma unroll
        for (int b = 0; b < 2; ++b)
#pragma unroll
            for (int m = 0; m < 4; ++m)
#pragma unroll
                for (int n = 0; n < 2; ++n) acc[a][b][m][n] = (f32x4){0.f, 0.f, 0.f, 0.f};
    bf16x8 At[4][2], B0[2][2], B1[2][2];
    const char* cA = P.a_base(cur); const char* cB = P.b_base(cur);
    if constexpr (Prob::GATHER) P.a_voff(cur, Rr, Cc, voffA);
    PG8_STAGE(PG8_SB(0, 0), cB, voffB); PG8_STAGE(PG8_SB(0, 1), cB + hstepB, voffB); PG8_STAGE(PG8_SA(0, 0), cA, voffA[0]); PG8_STAGE(PG8_SA(0, 1), cA, voffA[1]);
    if (wr == 1) PG8_BAR;
    PG8_WAIT_V(2); PG8_BAR;
    PG8_STAGE(PG8_SB(1, 0), cB + kstep, voffB); PG8_STAGE(PG8_SA(1, 0), cA + kstep, voffA[0]); PG8_STAGE(PG8_SB(1, 1), cB + hstepB + kstep, voffB);
    PG8_WAIT_V(6); PG8_BAR;
    for (;;) {
        const bool has_next = P.next(ui + 1, nxt);
        const char* nA = has_next ? P.a_base(nxt) : cA; const char* nB = has_next ? P.b_base(nxt) : cB;
        if constexpr (Prob::GATHER) {
            if (has_next) P.a_voff(nxt, Rr, Cc, nvoffA);
            else { nvoffA[0][0] = voffA[0][0]; nvoffA[0][1] = voffA[0][1]; nvoffA[1][0] = voffA[1][0]; nvoffA[1][1] = voffA[1][1]; }
        }
        for (int t = 0; t < nt; t += 2) {
            const bool last = (t == nt - 2);
            const char* a1 = cA + (size_t)(t + 1) * kstep;
            const char* a2 = last ? nA : cA + (size_t)(t + 2) * kstep; const char* b2 = last ? nB : cB + (size_t)(t + 2) * kstep;
            const char* a3 = a2 + kstep; const char* b3 = b2 + kstep;
            PG8_LDB(B0, 0, 0); PG8_LDB(B1, 0, 1); PG8_SCHED; PG8_LDA(At, 0, 0); PG8_STAGE(PG8_SA(1, 1), a1, voffA[1]);
            if constexpr (Prob::GATHER) { if (last) { voffA[0][0] = nvoffA[0][0]; voffA[0][1] = nvoffA[0][1]; voffA[1][0] = nvoffA[1][0]; voffA[1][1] = nvoffA[1][1]; } }
            PG8_WAIT_V(8); PG8_WAIT_L(0); PG8_BAR; PG8_MMA(0, 0, At, B0); PG8_MMA(0, 1, At, B1); PG8_BAR; PG8_SCHED;
            PG8_LDA(At, 0, 1); PG8_STAGE(PG8_SB(0, 0), b2, voffB); PG8_STAGE(PG8_SB(0, 1), b2 + hstepB, voffB); PG8_STAGE(PG8_SA(0, 0), a2, voffA[0]);
            PG8_WAIT_V(8); PG8_WAIT_L(0); PG8_BAR; PG8_MMA(1, 0, At, B0); PG8_MMA(1, 1, At, B1); PG8_BAR; PG8_SCHED;
            PG8_LDB(B0, 1, 0); PG8_LDB(B1, 1, 1); PG8_SCHED; PG8_LDA(At, 1, 0); PG8_STAGE(PG8_SA(0, 1), a2, voffA[1]);
            PG8_WAIT_V(8); PG8_WAIT_L(0); PG8_BAR; PG8_MMA(0, 0, At, B0); PG8_MMA(0, 1, At, B1); PG8_BAR; PG8_SCHED;
            PG8_LDA(At, 1, 1); PG8_STAGE(PG8_SB(1, 0), b3, voffB); PG8_STAGE(PG8_SB(1, 1), b3 + hstepB, voffB); PG8_STAGE(PG8_SA(1, 0), a3, voffA[0]);
            PG8_WAIT_V(8); PG8_WAIT_L(0); PG8_BAR; PG8_MMA(1, 0, At, B0); PG8_MMA(1, 1, At, B1); PG8_BAR; PG8_SCHED;
        }
        if constexpr (ALIGN_EPI) { if (wr == 0) PG8_BAR; }
        if constexpr (Epi::DRAIN_FIRST) __builtin_amdgcn_s_waitcnt(0x0F70);
        E(acc, cur, wr, wc, fr, fq);
        if (!has_next) break;
#pragma unroll
        for (int a = 0; a < 2; ++a)
#pragma unroll
            for (int b = 0; b < 2; ++b)
#pragma unroll
                for (int m = 0; m < 4; ++m)
#pragma unroll
                    for (int n = 0; n < 2; ++n) acc[a][b][m][n] = (f32x4){0.f, 0.f, 0.f, 0.f};
        cur = nxt; cA = nA; cB = nB; ++ui;
        if constexpr (ALIGN_EPI) { if (wr == 1) PG8_BAR; }
    }
    PG8_WAIT_V(0);
    if constexpr (!ALIGN_EPI) { if (wr == 0) PG8_BAR; }
    PG8_BAR;
#undef PG8_SA
#undef PG8_SB
#undef PG8_STAGE
#undef PG8_LDA
#undef PG8_LDB
#undef PG8_MMA
#undef PG8_WAIT_V
#undef PG8_WAIT_L
#undef PG8_BAR
#undef PG8_SCHED
}
}
using pg8::Unit;

struct ProbDense {
    static constexpr bool GATHER = false;
    const bf16_t* A; const bf16_t* Bt; int K, lda, ldb, nM, nN, G, c;
    __device__ __forceinline__ bool next(int i, Unit& u) const { u.e = 0; u.row0 = 0; u.nvalid = 256; return pg8::static_order(nM, nN, G, c, i, u.pm, u.pn); }
    __device__ __forceinline__ const char* a_base(const Unit& u) const { return (const char*)(A + (size_t)u.pm * 256 * lda); }
    __device__ __forceinline__ const char* b_base(const Unit& u) const { return (const char*)(Bt + (size_t)u.pn * 256 * ldb); }
    __device__ __forceinline__ void a_voff(const Unit&, const int*, const int*, unsigned (&)[2][2]) const {}
};
struct ProbWeff {
    static constexpr bool GATHER = false;
    const bf16_t* A; const bf16_t* Bt; int K, lda, ldb, G, c;
    __device__ __forceinline__ bool next(int i, Unit& u) const { const int L = i * G + c; if (L >= 32) return false; u.pm = L & 7; u.e = L >> 3; u.pn = 0; u.row0 = 0; u.nvalid = 256; return true; }
    __device__ __forceinline__ const char* a_base(const Unit& u) const { return (const char*)(A + (size_t)u.pm * 256 * lda + u.e * 256); }
    __device__ __forceinline__ const char* b_base(const Unit& u) const { return (const char*)(Bt + (size_t)u.e * 256 * 256); }
    __device__ __forceinline__ void a_voff(const Unit&, const int*, const int*, unsigned (&)[2][2]) const {}
};
struct EpiBf16 {
    static constexpr bool PERM = true, DRAIN_FIRST = false;
    bf16_t* O; int ldc; const float* scale; int mode;
    __device__ __forceinline__ void operator()(const f32x4 (&acc)[2][2][4][2], const Unit& u, int wr, int wc, int fr, int fq) const {
        const int rb = (mode == 2 ? u.row0 : u.pm * 256) + wr * 64 + fr; const int cb = (mode == 1 ? u.e * 256 : u.pn * 256) + wc * 32 + 8 * fq;
        f32x4 sv[2][2];
#pragma unroll
        for (int bj = 0; bj < 2; ++bj)
#pragma unroll
            for (int n = 0; n < 2; ++n) sv[bj][n] = scale ? *(const f32x4*)(scale + cb + bj * 128 + 4 * n) : (f32x4){1.f, 1.f, 1.f, 1.f};
#pragma unroll
        for (int ai = 0; ai < 2; ++ai)
#pragma unroll
            for (int m = 0; m < 4; ++m) { bf16_t* rowp = O + (size_t)(rb + ai * 128 + m * 16) * ldc + cb;
#pragma unroll
                for (int bj = 0; bj < 2; ++bj) { const f32x4 v0 = acc[ai][bj][m][0] * sv[bj][0], v1 = acc[ai][bj][m][1] * sv[bj][1];
                    u32x4 w; w.x = cvt_pk_bf16(v0[0], v0[1]); w.y = cvt_pk_bf16(v0[2], v0[3]); w.z = cvt_pk_bf16(v1[0], v1[1]); w.w = cvt_pk_bf16(v1[2], v1[3]);
                    *(u32x4*)(rowp + bj * 128) = w; } }
    }
};
struct EpiResF32 {
    static constexpr bool PERM = false, DRAIN_FIRST = true;
    const float* base; float* out; int ldc;
    __device__ __forceinline__ void operator()(const f32x4 (&acc)[2][2][4][2], const Unit& u, int wr, int wc, int fr, int fq) const {
        const int rb = u.pm * 256 + wr * 64 + fr, cb = u.pn * 256 + wc * 32 + 4 * fq;
#pragma unroll
        for (int ai = 0; ai < 2; ++ai) {
            f32x4 bs[4][2][2];
#pragma unroll
            for (int m = 0; m < 4; ++m) { const size_t off = (size_t)(rb + ai * 128 + m * 16) * ldc + cb;
#pragma unroll
                for (int bj = 0; bj < 2; ++bj)
#pragma unroll
                    for (int n = 0; n < 2; ++n) bs[m][bj][n] = *(const f32x4*)(base + off + bj * 128 + n * 16); }
            asm volatile("" ::: "memory");
#pragma unroll
            for (int m = 0; m < 4; ++m) { const size_t off = (size_t)(rb + ai * 128 + m * 16) * ldc + cb;
#pragma unroll
                for (int bj = 0; bj < 2; ++bj)
#pragma unroll
                    for (int n = 0; n < 2; ++n) *(f32x4*)(out + off + bj * 128 + n * 16) = bs[m][bj][n] + acc[ai][bj][m][n]; }
            asm volatile("" ::: "memory");
        }
    }
};
__device__ __forceinline__ float silu_mul(float g, float u) { const float e = __builtin_amdgcn_exp2f(g * -1.44269504089f); return g * __builtin_amdgcn_rcpf(1.0f + e) * u; }
namespace tt { constexpr int MAXRB = 36, STAGE = (MAXRB + 8) * 1024, NST = 3; }
struct Args { const float* in[16]; float* out; unsigned char* ws; };

__device__ __forceinline__ int swz_f(int r) { return ((r >> 1) & 7) ^ (((r >> 2) ^ (r >> 3)) & 1) ^ ((r >> 4) & 1); }
struct CvtTile { const float* src; bf16_t* dst; int ldw, ldt, n0; };
__device__ __forceinline__ CvtTile cvt_decode(int it, const float* w_in, const float* w_out, bf16_t* WIN, bf16_t* WOUT) {
    CvtTile t;
    constexpr int I_IN = 32 * 16;
    if (it < I_IN) { const int kb = it / 16, nb = it % 16; t.src = w_in + (size_t)(64 * kb) * INC + 256 * nb; t.dst = WIN + 64 * kb; t.ldw = INC; t.ldt = D; t.n0 = 256 * nb; return t; }
    const int r = it - I_IN, kb = r / 8, nb = r % 8; t.src = w_out + (size_t)(64 * kb) * D + 256 * nb; t.dst = WOUT + 64 * kb; t.ldw = D; t.ldt = D; t.n0 = 256 * nb;
    return t;
}
constexpr int CVT_NTILES = 32 * 16 + 32 * 8;

namespace tt8 {
using pg8::Unit;
constexpr int MAXRB = tt::MAXRB, STAGE = tt::STAGE, NST = tt::NST;
constexpr float SC_A = 8.0f, SC_B = 32.0f, SC_INV = 1.0f / (SC_A * SC_B);
__device__ __forceinline__ unsigned pack4_fp8(float a, float b, float c, float d) { int v = __builtin_amdgcn_cvt_pk_fp8_f32(a, b, 0, false); v = __builtin_amdgcn_cvt_pk_fp8_f32(c, d, v, true); return (unsigned)v; }
template <class Prob, class Epi>
__device__ __forceinline__ void gemm_phase(LAS unsigned char* lds, const Prob& P, const Epi& E) {
    int tid_ = threadIdx.x; asm volatile("" : "+v"(tid_));
    const int tid = tid_, wid = __builtin_amdgcn_readfirstlane(tid >> 6), lane = tid & 63, fr = lane & 15, fq = lane >> 4, wm = wid >> 1, wn = wid & 1;
    const int nt = P.K / 64;
    const int Rl = lane >> 2, Cb = 16 * ((lane & 3) ^ ((Rl >> 2) & 3));
    const int swr = ((fr >> 2) & 3) << 1, roff0 = fr * 64 + ((fq ^ swr) << 3), roff1 = fr * 64 + (((4 + fq) ^ swr) << 3);
    const int cq = lane & 31, kq = 2 * wid + (lane >> 5);
    int bw; { const int tc0 = 4 * cq, c32 = tc0 & 31, a_ = c32 >> 3, b_ = (c32 >> 2) & 1, rho0 = (tc0 & ~31) + 16 * b_ + 4 * a_;
        bw = (MAXRB + (rho0 >> 4)) * 1024 + (rho0 & 15) * 64 + ((((kq >> 1) ^ (a_ << 1)) & 7) << 3) + 4 * (kq & 1); }
    Unit u;
    for (int ui = 0; P.next(ui, u); ++ui) {
        const int RB = (u.nvalid + 15) >> 4, nblk = (RB - wm + 3) >> 2;
        const char* cA = P.a_base(u);
        const float* lB = P.b_base(u, cq >> 4) + 4 * (cq & 15) + (size_t)(4 * kq) * P.ldw;
        unsigned voffA[5]; int pidx[5];
#pragma unroll
        for (int i = 0; i < 5; ++i) { int p = wid + 8 * i; p = p < RB ? p : RB - 1; pidx[i] = p; voffA[i] = P.a_voff(u, 16 * p + Rl, Cb); }
        f32x4 acc[9][4];
#pragma unroll
        for (int i = 0; i < 9; ++i)
#pragma unroll
            for (int n = 0; n < 4; ++n) acc[i][n] = (f32x4){0.f, 0.f, 0.f, 0.f};
        f32x4 b0[4];
#define TT8_STAGE_A(st, kt) do { LAS unsigned char* sb_ = lds + (st) * STAGE; _Pragma("unroll") for (int i_ = 0; i_ < 5; ++i_) \
            __builtin_amdgcn_global_load_lds((const unsigned*)(cA + (size_t)(kt) * P.a_kstep + voffA[i_]), (LAS unsigned*)(sb_ + pidx[i_] * 1024), 16, 0, 0); } while (0)
#define TT8_LOAD_B(set, kt) do { const float* r_ = lB + (size_t)(kt) * 64 * P.ldw; _Pragma("unroll") for (int j_ = 0; j_ < 4; ++j_) { const float* p_ = r_ + (size_t)j_ * P.ldw; \
            asm volatile("global_load_dwordx4 %0, %1, off" : "=v"(set[j_]) : "v"(p_) : "memory"); } } while (0)
#define TT8_WRITE_B(set, st) do { _Pragma("unroll") for (int c_ = 0; c_ < 4; ++c_) \
            *(LAS unsigned*)(lds + (st) * STAGE + bw + 64 * c_) = pack4_fp8(set[0][c_] * SC_B, set[1][c_] * SC_B, set[2][c_] * SC_B, set[3][c_] * SC_B); } while (0)
#define TT8_WAIT(n, set) asm volatile("s_waitcnt vmcnt(" #n ")" : "+v"(set[0]), "+v"(set[1]), "+v"(set[2]), "+v"(set[3]) :: "memory")
        asm volatile("s_waitcnt vmcnt(0) lgkmcnt(0)" ::: "memory"); __builtin_amdgcn_s_barrier();
        TT8_LOAD_B(b0, 0); TT8_STAGE_A(0, 0);
        TT8_WAIT(5, b0); TT8_WRITE_B(b0, 0);
        TT8_LOAD_B(b0, 1); TT8_STAGE_A(1, 1);
        int st = 0;
#define TT8_AF(dst, g_) do { _Pragma("unroll") for (int i = 0; i < 3; ++i) { dst[i][0] = *(const LAS long*)(sa_ + (4 * (3 * (g_) + i) + wm) * 1024 + roff0); dst[i][1] = *(const LAS long*)(sa_ + (4 * (3 * (g_) + i) + wm) * 1024 + roff1); } } while (0)
#define TT8_MM(src, g_) do { __builtin_amdgcn_s_setprio(1); \
            _Pragma("unroll") for (int i = 0; i < 3; ++i) { if (3 * (g_) + i < nblk) { _Pragma("unroll") for (int ks = 0; ks < 2; ++ks) _Pragma("unroll") for (int nb = 0; nb < 4; ++nb) \
                acc[3 * (g_) + i][nb] = __builtin_amdgcn_mfma_f32_16x16x32_fp8_fp8(bf_[nb][ks], src[i][ks], acc[3 * (g_) + i][nb], 0, 0, 0); } } \
            __builtin_amdgcn_s_setprio(0); } while (0)
#define TT8_STEP(t, SET) do { \
            TT8_WAIT(5, SET); asm volatile("s_waitcnt lgkmcnt(0)" ::: "memory"); __builtin_amdgcn_s_barrier();     \
            int s1_ = st + 1; s1_ = s1_ >= NST ? s1_ - NST : s1_; int s2_ = s1_ + 1; s2_ = s2_ >= NST ? s2_ - NST : s2_; \
            TT8_WRITE_B(SET, s1_); \
            { const int t3_ = (t) + 2 < nt ? (t) + 2 : nt - 1; TT8_LOAD_B(SET, t3_); } \
            { const int t2_ = (t) + 2 < nt ? (t) + 2 : nt - 1; TT8_STAGE_A(s2_, t2_); } \
            const LAS unsigned char* sa_ = lds + st * STAGE; \
            long bf_[4][2]; _Pragma("unroll") for (int nb = 0; nb < 4; ++nb) { bf_[nb][0] = *(const LAS long*)(sa_ + (MAXRB + Prob::bsub(wn, nb)) * 1024 + roff0); bf_[nb][1] = *(const LAS long*)(sa_ + (MAXRB + Prob::bsub(wn, nb)) * 1024 + roff1); } \
            long afa_[3][2], afb_[3][2]; \
            TT8_AF(afa_, 0); TT8_AF(afb_, 1);        \
            TT8_MM(afa_, 0); \
            TT8_AF(afa_, 2); \
            TT8_MM(afb_, 1); \
            TT8_MM(afa_, 2); \
            st = s1_; } while (0)
        for (int t = 0; t < nt; ++t) { TT8_STEP(t, b0); }
        TT8_WAIT(0, b0);
        E(acc, u, RB, wm, wn, fr, fq);
#undef TT8_STAGE_A
#undef TT8_LOAD_B
#undef TT8_WRITE_B
#undef TT8_WAIT
#undef TT8_STEP
#undef TT8_AF
#undef TT8_MM
    }
    asm volatile("s_waitcnt vmcnt(0) lgkmcnt(0)" ::: "memory"); __builtin_amdgcn_s_barrier();
}
}
struct ProbTT8a {
    const unsigned char* A; const float* Wg; const float* Wu; const int* list; int K, lda, ldw; const volatile LAS int* ul; int nunits; static constexpr size_t a_kstep = 64;
    __device__ __forceinline__ bool next(int i, Unit& u) const { if (i >= nunits) return false; u.e = __builtin_amdgcn_readfirstlane(ul[8 * i]); u.pn = __builtin_amdgcn_readfirstlane(ul[8 * i + 1]);
        u.pm = __builtin_amdgcn_readfirstlane(ul[8 * i + 2]); u.row0 = __builtin_amdgcn_readfirstlane(ul[8 * i + 3]); u.nvalid = __builtin_amdgcn_readfirstlane(ul[8 * i + 4]); return true; }
    __device__ __forceinline__ const char* a_base(const Unit&) const { return (const char*)A; }
    __device__ __forceinline__ const float* b_base(const Unit& u, int par) const { return (par ? Wu : Wg) + (size_t)u.e * K * ldw + 64 * u.pn; }
    __device__ __forceinline__ unsigned a_voff(const Unit& u, int r, int cb) const { const int last = u.nvalid - 1; r = r < last ? r : last; const int tok = list[(size_t)u.e * T + u.pm * 576 + r]; return (unsigned)(tok * lda + cb); }
    static __device__ __forceinline__ int bsub(int wn, int nb) { return (nb >> 1) * 4 + 2 * wn + (nb & 1); }
};
struct EpiTT8Swiglu {
    unsigned char* O; int ldc;
    __device__ __forceinline__ void operator()(const f32x4 (&acc)[9][4], const Unit& u, int RB, int wm, int wn, int fr, int fq) const {
        unsigned char* base = O + ((size_t)u.pn * MAXSLOT + (size_t)(u.row0 + fr)) * 64 + 32 * wn + 8 * fq;
#pragma unroll
        for (int i = 0; i < 9; ++i) if (4 * i + wm < RB) {
            const f32x4 g0 = acc[i][0] * tt8::SC_INV, g1 = acc[i][1] * tt8::SC_INV, u0 = acc[i][2] * (tt8::SC_INV * tt8::SC_A), u1 = acc[i][3] * (tt8::SC_INV * tt8::SC_A);
#define SMC(g_, u_) __builtin_amdgcn_fmed3f(silu_mul(g_, u_), -440.0f, 440.0f)
            u32x2 w; w.x = tt8::pack4_fp8(SMC(g0[0], u0[0]), SMC(g0[1], u0[1]), SMC(g0[2], u0[2]), SMC(g0[3], u0[3]));
            w.y = tt8::pack4_fp8(SMC(g1[0], u1[0]), SMC(g1[1], u1[1]), SMC(g1[2], u1[2]), SMC(g1[3], u1[3]));
#undef SMC
            *(u32x2*)(base + (size_t)(16 * (4 * i + wm)) * 64) = w; }
    }
};
struct ProbTT8b {
    const unsigned char* A; const float* W; int K, lda, ldw; const volatile LAS int* ul; int nunits; static constexpr size_t a_kstep = (size_t)MAXSLOT * 64;
    __device__ __forceinline__ bool next(int i, Unit& u) const { if (i >= nunits) return false; u.e = __builtin_amdgcn_readfirstlane(ul[8 * i]); u.pn = __builtin_amdgcn_readfirstlane(ul[8 * i + 1]);
        u.pm = __builtin_amdgcn_readfirstlane(ul[8 * i + 2]); u.row0 = __builtin_amdgcn_readfirstlane(ul[8 * i + 3]); u.nvalid = __builtin_amdgcn_readfirstlane(ul[8 * i + 4]); return true; }
    __device__ __forceinline__ const char* a_base(const Unit& u) const { return (const char*)(A + (size_t)u.row0 * 64); }
    __device__ __forceinline__ const float* b_base(const Unit& u, int par) const { return W + (size_t)u.e * K * ldw + 128 * u.pn + 64 * par; }
    __device__ __forceinline__ unsigned a_voff(const Unit& u, int r, int cb) const { const int last = u.nvalid - 1; r = r < last ? r : last; return (unsigned)(r * 64 + cb); }
    static __device__ __forceinline__ int bsub(int wn, int nb) { return 4 * wn + nb; }
};
struct EpiTT8Y {
    bf16_t* O; int ldc;
    __device__ __forceinline__ void operator()(const f32x4 (&acc)[9][4], const Unit& u, int RB, int wm, int wn, int fr, int fq) const {
        bf16_t* base = O + (size_t)(u.row0 + fr) * ldc + 128 * u.pn + 64 * wn + 8 * fq;
#pragma unroll
        for (int i = 0; i < 9; ++i) if (4 * i + wm < RB) {
#pragma unroll
            for (int h = 0; h < 2; ++h) { const f32x4 a0 = acc[i][2 * h] * tt8::SC_INV, a1 = acc[i][2 * h + 1] * tt8::SC_INV;
                u32x4 w; w.x = cvt_pk_bf16(a0[0], a0[1]); w.y = cvt_pk_bf16(a0[2], a0[3]); w.z = cvt_pk_bf16(a1[0], a1[1]); w.w = cvt_pk_bf16(a1[2], a1[3]);
                *(u32x4*)(base + (size_t)(16 * (4 * i + wm)) * ldc + 32 * h) = w; } }
    }
};

__device__ __forceinline__ int build_tt_units(volatile LAS int* misc, unsigned* ctl, int vcu, int G) {
    volatile LAS int* cnt = misc + MISC_ETAB; volatile LAS int* nmt = cnt + 32; volatile LAS int* pst = nmt + 32;
    volatile LAS int* ul = misc + MISC_NUNIT + 8;
    int tid = threadIdx.x; asm volatile("" : "+v"(tid));
    __syncthreads();
    if (tid < 32) { const int c = (int)__hip_atomic_load(ctl + CW_ECNT + 64 * tid, RLX_AGENT); cnt[tid] = c; nmt[tid] = (c + 255) >> 8; }
    __syncthreads();
    if (tid == 0) {
        volatile LAS int* ubt = pst + 33;
        int p = 0, q = 0; for (int e = 0; e < 32; ++e) { pst[e] = p; ubt[e] = q; p += nmt[e] * 256; q += 16 * ((cnt[e] + 575) / 576); } pst[32] = p; ubt[32] = q;
        int n = 0, e = 0;
        for (int L = vcu; L < q; L += G) {
            while (L >= ubt[e + 1]) ++e;
            const int r = L - ubt[e], rc = r >> 4, pn = r & 15, nv = cnt[e] - 576 * rc;
            ul[8 * n] = e; ul[8 * n + 1] = pn; ul[8 * n + 2] = rc; ul[8 * n + 3] = pst[e] + 576 * rc; ul[8 * n + 4] = nv < 576 ? nv : 576;
            ul[8 * n + 5] = (pn > 0 && (L - pn) / G == L / G) ? 16 * (L - pn) : -1; ul[8 * n + 6] = -1; ul[8 * n + 7] = 16 * L;
            ++n;
        }
        misc[MISC_NUNIT] = n;
    }
    __syncthreads();
    return misc[MISC_NUNIT];
}

__global__ void __launch_bounds__(NTHREADS, 2) fwd_kernel(Args args) {
    extern __shared__ __attribute__((aligned(16))) unsigned char lds_raw[];
    LAS unsigned char* lds = (LAS unsigned char*)lds_raw;
    volatile LAS int* misc = (volatile LAS int*)(lds + MISC_OFF);
    const int tid = threadIdx.x, lane = tid & 63, wave = __builtin_amdgcn_readfirstlane(tid >> 6);
    const int G = gridDim.x, bx = blockIdx.x;
    const int vcu = (G % 8 == 0) ? (bx % 8) * (G / 8) + bx / 8 : bx;
    const int gw = vcu * NWAVES + wave, NGW = G * NWAVES;

    unsigned char* ws = args.ws;
    unsigned* ctl = (unsigned*)(ws + WS_CTL);
    const float* x = args.in[0]; const float* g1 = args.in[1]; const float* w_in = args.in[2]; const float* w_pool = args.in[3]; const float* pool_scale = args.in[4];
    const float* conv_w = args.in[5]; const float* w_out = args.in[6]; const float* g2 = args.in[7]; const float* w_rg = args.in[8]; const float* b_rg = args.in[9];
    const float* w_re = args.in[10]; const float* b_re = args.in[11]; const float* w_gate = args.in[12]; const float* w_up = args.in[13]; const float* w_down = args.in[14];
    const float* g3 = args.in[15];
    float* out = args.out;
    bf16_t* WRTH = (bf16_t*)(ws + WS_WRT + 512 * 1024); bf16_t* WRTL = (bf16_t*)(ws + WS_WRT + 768 * 1024); bf16_t* WPOOL = (bf16_t*)(ws + WS_WPOOL); int* LIST = (int*)(ws + WS_LIST); i32x4* ASG = (i32x4*)(ws + WS_ASG); f32x2* ASW = (f32x2*)(ws + WS_ASW);
    bf16_t* WIN = (bf16_t*)(ws + WS_WIN); bf16_t* WOUT = (bf16_t*)(ws + WS_WOUT); bf16_t* XN = (bf16_t*)(ws + WS_XN); bf16_t* PROJ = (bf16_t*)(ws + WS_PROJ);
    bf16_t* MIXED = (bf16_t*)(ws + WS_MIXED); bf16_t* MIXO = (bf16_t*)(ws + WS_X1); bf16_t* HID = (bf16_t*)(ws + WS_HID);
    bf16_t* Y = (bf16_t*)(ws + WS_Y);

    for (int u = tid; u < 1024; u += NTHREADS) misc[u] = 0;
    __syncthreads();
    XcdBarrier bar = xcd_barrier_post(ctl + CW_BAR, (volatile LAS unsigned*)(misc + MISC_BAR));

    for (int rep_ = 0; rep_ < REP_P0; ++rep_) {
    {
        {
            int it = vcu;
            f32x4 v[8];
            CvtTile cur = cvt_decode(it < CVT_NTILES ? it : 0, w_in, w_out, WIN, WOUT);
            if (it < CVT_NTILES) {
#pragma unroll
                for (int j = 0; j < 8; ++j) v[j] = __builtin_nontemporal_load((const f32x4*)(cur.src + (size_t)(8 * wave + j) * cur.ldw) + lane);
            }
            int buf = 0;
            while (it < CVT_NTILES) {
                LAS unsigned char* tb = lds + buf * 32768;
                u32x4 p[4];
#pragma unroll
                for (int c = 0; c < 4; ++c) { p[c].x = cvt_pk_bf16(v[0][c], v[1][c]); p[c].y = cvt_pk_bf16(v[2][c], v[3][c]); p[c].z = cvt_pk_bf16(v[4][c], v[5][c]); p[c].w = cvt_pk_bf16(v[6][c], v[7][c]); }
#pragma unroll
                for (int c = 0; c < 4; ++c) { const int r = 4 * lane + c; *(LAS u32x4*)(tb + r * 128 + ((wave ^ swz_f(r)) << 4)) = p[c]; }
                const int nit = it + G; const bool has_next = nit < CVT_NTILES;
                CvtTile nx = cvt_decode(has_next ? nit : 0, w_in, w_out, WIN, WOUT);
                if (has_next) {
#pragma unroll
                    for (int j = 0; j < 8; ++j) v[j] = __builtin_nontemporal_load((const f32x4*)(nx.src + (size_t)(8 * wave + j) * nx.ldw) + lane);
                }
                __syncthreads();
#pragma unroll
                for (int i = 0; i < 4; ++i) { const int r = (tid >> 3) + 64 * i, ch = tid & 7; const u32x4 o = *(const LAS u32x4*)(tb + r * 128 + ((ch ^ swz_f(r)) << 4));
                    *(u32x4*)(cur.dst + (size_t)(cur.n0 + r) * cur.ldt + 8 * ch) = o; }
                buf ^= 1; it = nit; cur = nx;
            }
            __syncthreads();
        }
        for (int i = bx * NTHREADS + tid; i < 4 * 65536; i += G * NTHREADS) { const int g = i >> 16, d = i & 255; WPOOL[i] = (bf16_t)f2bf(w_pool[i] * pool_scale[g * 256 + d]); }
        for (int i = bx * NTHREADS + tid; i < 48 * D; i += G * NTHREADS) { const int c = i / D, k = i % D; const float w = c < 4 ? w_rg[k * 4 + c] * g2[k] : (c < NRC ? w_re[k * 32 + (c - 4)] * g2[k] : 0.f);
            const unsigned hi = f2bf(w); const float wl = w - __builtin_bit_cast(float, hi << 16); WRTH[i] = (bf16_t)hi; WRTL[i] = (bf16_t)f2bf(wl); }
        for (int m = gw; m < T; m += NGW) {
            const f32x4* xr = (const f32x4*)(x + (size_t)m * D) + lane; f32x4 v[8]; float s = 0.f;
#pragma unroll
            for (int j = 0; j < 8; ++j) { v[j] = xr[64 * j]; s += (v[j].x * v[j].x + v[j].y * v[j].y) + (v[j].z * v[j].z + v[j].w * v[j].w); }
            const float rstd = 1.0f / sqrtf(wave_sum(s) * (1.0f / D) + EPS);
            u32x2* o = (u32x2*)(XN + (size_t)m * D) + lane;
#pragma unroll
            for (int j = 0; j < 8; ++j) { const f32x4 g = ((const f32x4*)g1)[64 * j + lane]; u32x2 w; w.x = pk2(v[j].x * rstd * g.x, v[j].y * rstd * g.y); w.y = pk2(v[j].z * rstd * g.z, v[j].w * rstd * g.w); o[64 * j] = w; }
        }
    }
    xcd_barrier(bar);
    }

    for (int rep_ = 0; rep_ < REP_P1; ++rep_) {
    {
        ProbDense P{XN, WIN, D, D, D, T / 256, INC / 256, G, bx};
        EpiBf16 E{PROJ, INC, nullptr, 0};
        pg8::gemm_phase<ProbDense, EpiBf16, true>(lds, P, E);
    }
    xcd_barrier(bar);
    }

    for (int rep_ = 0; rep_ < REP_P2; ++rep_) {
    {
        if (rep_ == 0) { ProbWeff P{WOUT, WPOOL, 256, D, 256, G, vcu}; EpiBf16 E{WOUT, D, nullptr, 1}; pg8::gemm_phase<ProbWeff, EpiBf16, false>(lds, P, E); }
        bf16_t* const POOLDST = MIXED; constexpr int POOLLD = D;
        for (int it = gw; it < 2048; it += NGW) {
            const int part = it >> 10, q = it & 1023, chunk = q >> 1, slab = q & 1, r0 = chunk * 16, c0 = slab * 512 + lane * 8;
#define BF8(v, f) { f[0] = bflo(v.x); f[1] = bfhi(v.x); f[2] = bflo(v.y); f[3] = bfhi(v.y); f[4] = bflo(v.z); f[5] = bfhi(v.z); f[6] = bflo(v.w); f[7] = bfhi(v.w); }
            if (part == 0) {
                const int gi = c0 >> 8, w = 2 << gi;
                float s[8];
#pragma unroll
                for (int j = 0; j < 8; ++j) s[j] = 0.f;
                { u32x4 iv[16];
#pragma unroll
                  for (int i = 0; i < 16; ++i) { const int rr = r0 - 1 - i; iv[i] = *(const u32x4*)(PROJ + (size_t)(rr < 0 ? 0 : rr) * INC + c0); }
#pragma unroll
                  for (int i = 0; i < 16; ++i) { const bool ok = (i < w) && (r0 - 1 - i >= 0); float f[8]; BF8(iv[i], f);
#pragma unroll
                      for (int j = 0; j < 8; ++j) s[j] += ok ? f[j] : 0.f; } }
#pragma unroll 1
                for (int tb = 0; tb < 2; ++tb) {
                    const int t0 = r0 + 8 * tb; u32x4 nv[8], ov[8];
#pragma unroll
                    for (int k = 0; k < 8; ++k) { nv[k] = *(const u32x4*)(PROJ + (size_t)(t0 + k) * INC + c0); const int ro = t0 + k - w; ov[k] = *(const u32x4*)(PROJ + (size_t)(ro < 0 ? 0 : ro) * INC + c0); }
#pragma unroll
                    for (int k = 0; k < 8; ++k) { const int t = t0 + k; float un[8], uo[8]; BF8(nv[k], un); BF8(ov[k], uo); const bool ok = t - w >= 0;
#pragma unroll
                        for (int j = 0; j < 8; ++j) s[j] += un[j] - (ok ? uo[j] : 0.f);
                        const int cn = (t + 1) < w ? (t + 1) : w; const float inv = 1.0f / (float)cn;
                        u32x4 p; p.x = pk2(s[0] * inv - un[0], s[1] * inv - un[1]); p.y = pk2(s[2] * inv - un[2], s[3] * inv - un[3]);
                        p.z = pk2(s[4] * inv - un[4], s[5] * inv - un[5]); p.w = pk2(s[6] * inv - un[6], s[7] * inv - un[7]);
                        *(u32x4*)(POOLDST + (size_t)t * POOLLD + c0) = p; }
                }
            } else {
                float cw[8][3];
#pragma unroll
                for (int j = 0; j < 8; ++j) { cw[j][0] = conv_w[(c0 + j) * 3 + 0]; cw[j][1] = conv_w[(c0 + j) * 3 + 1]; cw[j][2] = conv_w[(c0 + j) * 3 + 2]; }
                float z2[8], z1[8];
                { const int ra = r0 >= 2 ? r0 - 2 : 0, rb = r0 >= 1 ? r0 - 1 : 0;
                  const u32x4 ca = *(const u32x4*)(PROJ + (size_t)ra * INC + MIXA + MIXB + c0), va = *(const u32x4*)(PROJ + (size_t)ra * INC + MIXA + 2 * MIXB + c0);
                  const u32x4 cb = *(const u32x4*)(PROJ + (size_t)rb * INC + MIXA + MIXB + c0), vb = *(const u32x4*)(PROJ + (size_t)rb * INC + MIXA + 2 * MIXB + c0);
                  float fa[8], fb[8], fc[8], fd[8]; BF8(ca, fa); BF8(va, fb); BF8(cb, fc); BF8(vb, fd);
#pragma unroll
                  for (int j = 0; j < 8; ++j) { z2[j] = r0 >= 2 ? fa[j] * fb[j] : 0.f; z1[j] = r0 >= 1 ? fc[j] * fd[j] : 0.f; } }
#pragma unroll 1
                for (int tb = 0; tb < 2; ++tb) {
                    const int t0 = r0 + 8 * tb; u32x4 bbv[8], ccv[8], vvv[8];
#pragma unroll
                    for (int k = 0; k < 8; ++k) { const bf16_t* pr = PROJ + (size_t)(t0 + k) * INC + c0; bbv[k] = *(const u32x4*)(pr + MIXA); ccv[k] = *(const u32x4*)(pr + MIXA + MIXB); vvv[k] = *(const u32x4*)(pr + MIXA + 2 * MIXB); }
#pragma unroll
                    for (int k = 0; k < 8; ++k) { float bg[8], cg[8], vg[8]; BF8(bbv[k], bg); BF8(ccv[k], cg); BF8(vvv[k], vg); float yv[8];
#pragma unroll
                        for (int j = 0; j < 8; ++j) { const float z0 = cg[j] * vg[j]; yv[j] = bg[j] * (z2[j] * cw[j][0] + z1[j] * cw[j][1] + z0 * cw[j][2]); z2[j] = z1[j]; z1[j] = z0; }
                        u32x4 p; p.x = pk2(yv[0], yv[1]); p.y = pk2(yv[2], yv[3]); p.z = pk2(yv[4], yv[5]); p.w = pk2(yv[6], yv[7]);
                        *(u32x4*)(MIXED + (size_t)(t0 + k) * D + MIXA + c0) = p; }
                }
            }
#undef BF8
        }
    }
    xcd_barrier(bar);
    }

    for (int rep_ = 0; rep_ < REP_P4; ++rep_) {
    {
        ProbDense P{MIXED, WOUT, D, D, D, T / 256, D / 256, G, bx};
        EpiBf16 E{MIXO, D, nullptr, 0};
        pg8::gemm_phase<ProbDense, EpiBf16, false>(lds, P, E);
    }
    xcd_barrier(bar);
    }

    for (int rep_ = 0; rep_ < REP_P5; ++rep_) {
    {
        bf16_t* H2 = XN;
        for (int rb = vcu; rb < T / 32; rb += G) {
            const int row0 = rb * 32 + wave * 4;
            float rstd[4]; float mylog[4];
            {
                LAS float* red = (LAS float*)lds;
                LAS float* ssp = red + 8 * 6 * 64 * 4;
                LAS float* lgs = ssp + 8 * 2 * 64;
                LAS float* rsd = lgs + 32 * 48;
                const int rowb = rb * 32, fr = lane & 15, fq = lane >> 4;
                f32x4 acc[2][3];
#pragma unroll
                for (int a = 0; a < 2; ++a)
#pragma unroll
                    for (int c = 0; c < 3; ++c) acc[a][c] = (f32x4){0.f, 0.f, 0.f, 0.f};
                float ssl[2] = {0.f, 0.f};
#pragma unroll 2
                for (int ks = 0; ks < 8; ++ks) {
                    const int k0 = 256 * wave + 32 * ks + 8 * fq;
                    bf16x8 bh[3], bl[3];
#pragma unroll
                    for (int c = 0; c < 3; ++c) { bh[c] = *(const bf16x8*)(WRTH + (size_t)(16 * c + fr) * D + k0); bl[c] = *(const bf16x8*)(WRTL + (size_t)(16 * c + fr) * D + k0); }
#pragma unroll
                    for (int a = 0; a < 2; ++a) { const size_t ro = (size_t)(rowb + 16 * a + fr) * D + k0;
                        const f32x4 xa = *(const f32x4*)(x + ro), xb = *(const f32x4*)(x + ro + 4); const u32x4 mo = *(const u32x4*)(MIXO + ro);
                        const float v[8] = {xa.x + bflo(mo.x), xa.y + bfhi(mo.x), xa.z + bflo(mo.y), xa.w + bfhi(mo.y), xb.x + bflo(mo.z), xb.y + bfhi(mo.z), xb.z + bflo(mo.w), xb.w + bfhi(mo.w)};
                        u32x4 hp, lp;
#pragma unroll
                        for (int q = 0; q < 4; ++q) { const unsigned h = cvt_pk_bf16(v[2 * q], v[2 * q + 1]); hp[q] = h; lp[q] = cvt_pk_bf16(v[2 * q] - bflo(h), v[2 * q + 1] - bfhi(h));
                            ssl[a] += v[2 * q] * v[2 * q] + v[2 * q + 1] * v[2 * q + 1]; }
                        const bf16x8 ah = __builtin_bit_cast(bf16x8, hp), al = __builtin_bit_cast(bf16x8, lp);
#pragma unroll
                        for (int c = 0; c < 3; ++c) { acc[a][c] = __builtin_amdgcn_mfma_f32_16x16x32_bf16(ah, bh[c], acc[a][c], 0, 0, 0); acc[a][c] = __builtin_amdgcn_mfma_f32_16x16x32_bf16(ah, bl[c], acc[a][c], 0, 0, 0);
                            acc[a][c] = __builtin_amdgcn_mfma_f32_16x16x32_bf16(al, bh[c], acc[a][c], 0, 0, 0); } }
                }
#pragma unroll
                for (int a = 0; a < 2; ++a) { ssp[(wave * 2 + a) * 64 + lane] = ssl[a];
#pragma unroll
                    for (int c = 0; c < 3; ++c) *(LAS f32x4*)(red + ((wave * 6 + a * 3 + c) * 64 + lane) * 4) = acc[a][c]; }
                __syncthreads();
#pragma unroll
                for (int i = 0; i < 3; ++i) { const int o = tid + 512 * i, r = o / 48, c = o - 48 * r, a = r >> 4, rr = r & 15, cb = c >> 4, cc = c & 15, ln = cc + 16 * (rr >> 2), reg = rr & 3; float s = 0.f;
#pragma unroll
                    for (int w = 0; w < 8; ++w) s += red[((w * 6 + a * 3 + cb) * 64 + ln) * 4 + reg];
                    lgs[o] = s; }
                if (tid < 32) { const int a = tid >> 4, rr = tid & 15; float s = 0.f;
#pragma unroll
                    for (int w = 0; w < 8; ++w)
#pragma unroll
                        for (int q = 0; q < 4; ++q) s += ssp[(w * 2 + a) * 64 + rr + 16 * q];
                    rsd[tid] = 1.0f / sqrtf(s * (1.0f / D) + EPS); }
                __syncthreads();
#pragma unroll
                for (int r = 0; r < 4; ++r) { rstd[r] = rsd[4 * wave + r]; mylog[r] = (lane < 48 ? lgs[(4 * wave + r) * 48 + lane] : 0.f) * rstd[r]; }
            }
#pragma unroll
            for (int j = 0; j < 8; ++j) { const f32x4 g = ((const f32x4*)g2)[64 * j + lane];
#pragma unroll
                for (int r = 0; r < 4; ++r) { const u32x2 mo = *((const u32x2*)(MIXO + (size_t)(row0 + r) * D + 256 * j) + lane); f32x4 xv = *((const f32x4*)(x + (size_t)(row0 + r) * D + 256 * j) + lane);
                    xv.x += bflo(mo.x); xv.y += bfhi(mo.x); xv.z += bflo(mo.y); xv.w += bfhi(mo.y);
                    const float sc = rstd[r] * tt8::SC_A;
                    ((unsigned*)((unsigned char*)H2 + (size_t)(row0 + r) * D))[64 * j + lane] = tt8::pack4_fp8(xv.x * sc * g.x, xv.y * sc * g.y, xv.z * sc * g.z, xv.w * sc * g.w);
                } }
            const float bias = lane < 4 ? b_rg[lane] : (lane < NRC ? b_re[lane - 4] : 0.f);
#pragma unroll
            for (int r = 0; r < 4; ++r) {
                const float lg = mylog[r] + bias;
                float g[4];
#pragma unroll
                for (int i = 0; i < 4; ++i) g[i] = __shfl(lg, i);
                int grp = 0; float gm = g[0];
#pragma unroll
                for (int i = 1; i < 4; ++i) if (g[i] > gm) { gm = g[i]; grp = i; }
                float gs = 0.f;
#pragma unroll
                for (int i = 0; i < 4; ++i) gs += expf(g[i] - gm);
                const float g_w = 1.0f / gs;
                float el[8];
#pragma unroll
                for (int i = 0; i < 8; ++i) el[i] = __shfl(lg, 4 + grp * 8 + i);
                int i0 = 0; float m0 = el[0];
#pragma unroll
                for (int i = 1; i < 8; ++i) if (el[i] > m0) { m0 = el[i]; i0 = i; }
                int i1 = -1; float m1 = -3.0e38f;
#pragma unroll
                for (int i = 0; i < 8; ++i) if (i != i0 && el[i] > m1) { m1 = el[i]; i1 = i; }
                const float p1 = expf(m1 - m0);
                const float w0 = g_w / (1.0f + p1), w1 = g_w * p1 / (1.0f + p1);
                if (lane == 0) { const int a = (wave * 4 + r) * 2; misc[256 + a] = grp * 8 + i0; misc[256 + a + 1] = grp * 8 + i1;
                    misc[384 + a] = __builtin_bit_cast(int, w0); misc[384 + a + 1] = __builtin_bit_cast(int, w1); }
            }
            __syncthreads();
            if (wave == 0) {
                const int a = lane, tok = rb * 32 + (a >> 1), e = misc[256 + a];
                unsigned long long mym = 0ull;
#pragma unroll 1
                for (int ee = 0; ee < NE; ++ee) { const unsigned long long m = __ballot(e == ee); if (e == ee) mym = m; }
                const int rank = __popcll(mym & ((1ull << lane) - 1ull)), cntl = __popcll(mym), leader = __ffsll((long long)mym) - 1;
                int base = 0;
                if (rank == 0) base = (int)__hip_atomic_fetch_add(ctl + CW_ECNT + 64 * e + (rep_ == REP_P5 - 1 ? 0 : 32), (unsigned)cntl, RLX_AGENT);
                base = __shfl(base, leader);
                const int pos = base + rank;
                LIST[(size_t)e * T + pos] = tok;
                ((int*)ASG)[(size_t)tok * 4 + (a & 1) * 2] = e; ((int*)ASG)[(size_t)tok * 4 + (a & 1) * 2 + 1] = pos;
                ((int*)ASW)[(size_t)tok * 2 + (a & 1)] = misc[384 + a];
            }
            __syncthreads();
        }
    }
    xcd_barrier(bar);
    }

    for (int rep_ = 0; rep_ < REP_P67; ++rep_) {
    {
        const int nu = build_tt_units(misc, ctl, vcu, G);
        ProbTT8a P{(const unsigned char*)XN, w_gate, w_up, LIST, D, D, DE, misc + MISC_NUNIT + 8, nu};
        EpiTT8Swiglu E{(unsigned char*)HID, DE};
        for (int r6_ = 0; r6_ < REP_P6; ++r6_) { if (r6_) xcd_barrier(bar); tt8::gemm_phase<ProbTT8a, EpiTT8Swiglu>(lds, P, E); }
    }
    xcd_barrier(bar);

    {
        const int nu = build_tt_units(misc, ctl, vcu, G);
        ProbTT8b P{(const unsigned char*)HID, w_down, DE, DE, D, misc + MISC_NUNIT + 8, nu};
        EpiTT8Y E{Y, D};
        for (int r7_ = 0; r7_ < REP_P7; ++r7_) { if (r7_) xcd_barrier(bar); tt8::gemm_phase<ProbTT8b, EpiTT8Y>(lds, P, E); }
    }
    xcd_barrier(bar);

    }
    for (int rep_ = 0; rep_ < REP_P8; ++rep_) {
    if (rep_) xcd_barrier(bar);
    {
        volatile LAS int* pst = misc + MISC_ETAB + 64;
        for (int m = gw; m < T; m += NGW) {
            const i32x4 as = ASG[m]; const f32x2 aw = ASW[m];
            const int s0 = pst[as.x] + as.y, s1 = pst[as.z] + as.w;
            const f32x4* xr = (const f32x4*)(x + (size_t)m * D) + lane; const u32x2* mo_ = (const u32x2*)(MIXO + (size_t)m * D) + lane; const u32x2* y0 = (const u32x2*)(Y + (size_t)s0 * D) + lane; const u32x2* y1 = (const u32x2*)(Y + (size_t)s1 * D) + lane;
            f32x4 v[8]; float s = 0.f;
#pragma unroll
            for (int j = 0; j < 8; ++j) { f32x4 xx = xr[64 * j]; const u32x2 a = y0[64 * j], b = y1[64 * j], mo = mo_[64 * j];
                xx.x += bflo(mo.x); xx.y += bfhi(mo.x); xx.z += bflo(mo.y); xx.w += bfhi(mo.y);
                v[j].x = xx.x + aw.x * bflo(a.x) + aw.y * bflo(b.x); v[j].y = xx.y + aw.x * bfhi(a.x) + aw.y * bfhi(b.x);
                v[j].z = xx.z + aw.x * bflo(a.y) + aw.y * bflo(b.y); v[j].w = xx.w + aw.x * bfhi(a.y) + aw.y * bfhi(b.y);
                s += (v[j].x * v[j].x + v[j].y * v[j].y) + (v[j].z * v[j].z + v[j].w * v[j].w); }
            const float rstd = 1.0f / sqrtf(wave_sum(s) * (1.0f / D) + EPS);
            f32x4* o = (f32x4*)(out + (size_t)m * D) + lane;
#pragma unroll
            for (int j = 0; j < 8; ++j) { const f32x4 g = ((const f32x4*)g3)[64 * j + lane]; o[64 * j] = (f32x4){v[j].x * rstd * g.x, v[j].y * rstd * g.y, v[j].z * rstd * g.z, v[j].w * rstd * g.w}; }
        }
    }
    }
}

extern "C" void kernel_launch(void* const* d_in, const int* in_sizes, int n_in, void* d_out, int out_size, void* d_ws, size_t ws_size, hipStream_t stream) {
    static int grid = 0;
    if (grid == 0) {
        if (n_in != 16 || in_sizes[0] != T * D || out_size != T * D || ws_size < WS_END) { fprintf(stderr, "kernel_launch: unexpected shapes (n_in %d, in0 %d, out %d, ws %zu); nothing launched\n", n_in, n_in > 0 ? in_sizes[0] : -1, out_size, ws_size); grid = -1; return; }
        int dev = 0, cus = 0, per_cu = 0;
        if (hipGetDevice(&dev) != hipSuccess || hipDeviceGetAttribute(&cus, hipDeviceAttributeMultiprocessorCount, dev) != hipSuccess) { fprintf(stderr, "kernel_launch: device query failed\n"); grid = -1; return; }
        if (hipFuncSetAttribute((const void*)fwd_kernel, hipFuncAttributeMaxDynamicSharedMemorySize, LDS_BYTES) != hipSuccess) { fprintf(stderr, "kernel_launch: hipFuncSetAttribute failed\n"); grid = -1; return; }
        if (hipOccupancyMaxActiveBlocksPerMultiprocessor(&per_cu, (const void*)fwd_kernel, NTHREADS, LDS_BYTES) != hipSuccess || per_cu < 1) { fprintf(stderr, "kernel_launch: occupancy query says %d blocks per CU; nothing launched\n", per_cu); (void)hipGetLastError(); grid = -1; return; }
        grid = cus;
    }
    if (grid < 0) return;
    if (hipMemsetAsync((char*)d_ws + WS_CTL, 0, CTL_BYTES, stream) != hipSuccess) { fprintf(stderr, "kernel_launch: memset failed\n"); return; }
    Args a{};
    for (int i = 0; i < 16; ++i) a.in[i] = (const float*)d_in[i];
    a.out = (float*)d_out; a.ws = (unsigned char*)d_ws;
    void* kargs[] = {&a};
    hipError_t le = hipLaunchCooperativeKernel((const void*)fwd_kernel, dim3(grid), dim3(NTHREADS), kargs, LDS_BYTES, stream);
    if (le != hipSuccess) fprintf(stderr, "kernel_launch: cooperative launch failed: %s (grid %d)\n", hipGetErrorString(le), grid);
}
```

```cpp
#include <hip/hip_runtime.h>
#include <cstdio>
#include <cstdint>

#define LAS __attribute__((address_space(3)))
#define GAS __attribute__((address_space(1)))
typedef unsigned short bf16_t;
typedef short bf16x8 __attribute__((ext_vector_type(8)));
typedef float f32x4 __attribute__((ext_vector_type(4)));
typedef float f32x2 __attribute__((ext_vector_type(2)));
typedef unsigned u32x4 __attribute__((ext_vector_type(4)));
typedef unsigned u32x2 __attribute__((ext_vector_type(2)));
typedef int i32x4 __attribute__((ext_vector_type(4)));

#ifndef REP_P0
#define REP_P0 1
#endif
#ifndef REP_P1
#define REP_P1 1
#endif
#ifndef REP_P2
#define REP_P2 1
#endif
#ifndef REP_P3
#define REP_P3 1
#endif
#ifndef REP_P4
#define REP_P4 1
#endif
#ifndef REP_P5
#define REP_P5 1
#endif
#ifndef REP_P6
#define REP_P6 1
#endif
#ifndef REP_P7
#define REP_P7 1
#endif
#ifndef REP_P67
#define REP_P67 1
#endif
#ifndef REP_P8
#define REP_P8 1
#endif
constexpr int T = 8192, D = 2048, INC = 4096, MIXA = 1024, MIXB = 1024, NE = 32, DE = 1024, NGRP = 4, EPG = 8;
constexpr int POOLCH = 256, NRC = 36;
constexpr float EPS = 1e-6f;
constexpr int MAXSLOT = 24576;
constexpr int NWAVES = 8, NTHREADS = 512;

constexpr size_t MiB = 1u << 20;
constexpr size_t WS_CTL = 0, CTL_BYTES = 64 * 1024;
constexpr size_t WS_WRT = 1 * MiB;
constexpr size_t WS_WPOOL = 2 * MiB;
constexpr size_t WS_LIST = 3 * MiB;
constexpr size_t WS_ASG = 4 * MiB;
constexpr size_t WS_ASW = 5 * MiB;
constexpr size_t WS_WIN = 8 * MiB;
constexpr size_t WS_WOUT = 24 * MiB;
constexpr size_t WS_XN = 32 * MiB;
constexpr size_t WS_PROJ = 64 * MiB;
constexpr size_t WS_MIXED = 144 * MiB;
constexpr size_t WS_X1 = 176 * MiB;
constexpr size_t WS_HID = 240 * MiB;
constexpr size_t WS_Y = 288 * MiB;
constexpr size_t WS_END = 384 * MiB;
constexpr int CW_ECNT = 1024;
constexpr int CW_BAR = 4096;

constexpr int RING_BYTES = 135168;
constexpr int MISC_OFF = RING_BYTES;
constexpr int MISC_BAR = 0;
constexpr int MISC_ETAB = 16;
constexpr int MISC_NUNIT = 160;
constexpr int LDS_BYTES = 147456;

#define LDS_WAIT() asm volatile("s_waitcnt lgkmcnt(0)" ::: "memory")
#define VM_WAIT() asm volatile("s_waitcnt vmcnt(0)" ::: "memory")
#define RLX_AGENT __ATOMIC_RELAXED, __HIP_MEMORY_SCOPE_AGENT

__device__ __forceinline__ unsigned f2bf(float f) { unsigned u = __builtin_bit_cast(unsigned, f); return (u + 0x7fffu + ((u >> 16) & 1u)) >> 16; }
__device__ __forceinline__ unsigned pk2(float lo, float hi) { return f2bf(lo) | (f2bf(hi) << 16); }
__device__ __forceinline__ unsigned cvt_pk_bf16(float lo, float hi) { unsigned r; asm volatile("v_cvt_pk_bf16_f32 %0, %1, %2" : "=v"(r) : "v"(lo), "v"(hi)); return r; }
__device__ __forceinline__ float bflo(unsigned w) { return __builtin_bit_cast(float, w << 16); }
__device__ __forceinline__ float bfhi(unsigned w) { return __builtin_bit_cast(float, w & 0xffff0000u); }
__device__ __forceinline__ float wave_sum(float v) {
#pragma unroll
    for (int o = 1; o < 64; o <<= 1) v += __shfl_xor(v, o);
    return v;
}

__device__ __forceinline__ float wave_sum_dpp(float v) {
    v += __builtin_bit_cast(float, __builtin_amdgcn_update_dpp(0, __builtin_bit_cast(int, v), 0xB1, 0xF, 0xF, false));
    v += __builtin_bit_cast(float, __builtin_amdgcn_update_dpp(0, __builtin_bit_cast(int, v), 0x4E, 0xF, 0xF, false));
    v += __builtin_bit_cast(float, __builtin_amdgcn_update_dpp(0, __builtin_bit_cast(int, v), 0x141, 0xF, 0xF, false));
    v += __builtin_bit_cast(float, __builtin_amdgcn_update_dpp(0, __builtin_bit_cast(int, v), 0x140, 0xF, 0xF, false));
    v += __builtin_bit_cast(float, __builtin_amdgcn_update_dpp(0, __builtin_bit_cast(int, v), 0x142, 0xA, 0xF, false));
    v += __builtin_bit_cast(float, __builtin_amdgcn_update_dpp(0, __builtin_bit_cast(int, v), 0x143, 0xC, 0xF, false));
    return __builtin_bit_cast(float, __builtin_amdgcn_readlane(__builtin_bit_cast(int, v), 63));
}

#define XB_TMO      128
#define XB_XCNT(j)  (256  + 64 * (j))
#define XB_XSUB(j)  (1280 + 64 * (j))
#define XB_XGEN(j)  (2304 + 64 * (j))
#define XB_TOP      3328
#define XB_TOPGEN   3392
#define XCD_BAR_WORDS 3456
#define XB_SPIN_CAP (1u << 18)
__device__ __forceinline__ unsigned xb_ld(unsigned* p)              { return __hip_atomic_load(p, __ATOMIC_RELAXED, __HIP_MEMORY_SCOPE_AGENT); }
__device__ __forceinline__ unsigned xb_add(unsigned* p, unsigned v) { return __hip_atomic_fetch_add(p, v, __ATOMIC_RELAXED, __HIP_MEMORY_SCOPE_AGENT); }
__device__ __forceinline__ unsigned xb_xcc_id() { return (unsigned)__builtin_amdgcn_s_getreg((3 << 11) | 20) & 0xFu; }
#define XB_SPIN(cond, bar) do { unsigned _sp = 0; while (cond) { __builtin_amdgcn_s_sleep(1); \
    if ((++_sp & 255u) == 0u) { if (xb_ld(&(bar)[XB_TMO])) break; if (_sp > XB_SPIN_CAP) { atomicAdd(&(bar)[XB_TMO], 1u); break; } } } } while (0)
struct XcdBarrier { unsigned* bar; unsigned x; volatile LAS unsigned* st; };
__device__ __forceinline__ XcdBarrier xcd_barrier_post(unsigned* bar, volatile LAS unsigned* st) {
    XcdBarrier b; b.bar = bar; b.x = xb_xcc_id(); b.st = st;
    if (threadIdx.x == 0) (void)xb_add(&bar[XB_XCNT(b.x)], 1u);
    return b;
}
__device__ __forceinline__ void xcd_barrier_complete(unsigned* bar, unsigned x, unsigned& nloc, unsigned& nx) {
    const unsigned G = gridDim.x * gridDim.y * gridDim.z;
    unsigned sum, cnt, mine, sp = 0u;
    for (;;) {
        sum = 0u; cnt = 0u; mine = 0u;
#pragma unroll
        for (unsigned j = 0; j < 16; ++j) { const unsigned c = xb_ld(&bar[XB_XCNT(j)]); sum += c; cnt += (c > 0u) ? 1u : 0u; mine = (j == x) ? c : mine; }
        if (sum == G) break;
        __builtin_amdgcn_s_sleep(1);
        if ((++sp & 255u) == 0u) { if (xb_ld(&bar[XB_TMO])) break; if (sp > XB_SPIN_CAP) { atomicAdd(&bar[XB_TMO], 1u); break; } }
    }
    nloc = mine > 0u ? mine : 1u; nx = cnt > 0u ? cnt : 1u;
}
__device__ __forceinline__ void xcd_barrier(const XcdBarrier& b) {
    asm volatile("s_waitcnt vmcnt(0)" ::: "memory");
    __syncthreads();
    if (threadIdx.x == 0) {
        unsigned* bar = b.bar;
        __builtin_amdgcn_s_waitcnt(0);
        unsigned nloc = b.st[0], nx = b.st[1];
        if (nloc == 0u) { xcd_barrier_complete(bar, b.x, nloc, nx); b.st[0] = nloc; b.st[1] = nx; }
        const unsigned old = xb_add(&bar[XB_XSUB(b.x)], 1u);
        const unsigned gen = old / nloc;
        if (old + 1u == (gen + 1u) * nloc) {
            __builtin_amdgcn_fence(__ATOMIC_RELEASE, "agent");
            asm volatile("s_waitcnt vmcnt(0)" ::: "memory");
            (void)xb_add(&bar[XB_TOP], 1u);
        }
        XB_SPIN(xb_ld(&bar[XB_TOP]) < (gen + 1u) * nx, bar);
        __builtin_amdgcn_fence(__ATOMIC_ACQUIRE, "agent");
        asm volatile("s_waitcnt vmcnt(0)" ::: "memory");
    }
    __syncthreads();
}

namespace pg8 {
constexpr int BM = 256, BK = 64, HALF = 128, HTB = HALF * BK * 2, NXCD = 8, WGM = 8;
__host__ __device__ __forceinline__ int lds_byte(int r, int c) { const int st = (r >> 4) * 2 + (c >> 5), rr = r & 15, cc = c & 31, ob = rr * 64 + cc * 2; return st * 1024 + (ob ^ (((ob >> 9) & 1) << 5)); }
__host__ __device__ __forceinline__ void stage_rc(int b, int& R, int& C) { const int st = b / 1024, sb = b % 1024, swz = sb ^ (((sb >> 9) & 1) << 5); R = (st >> 1) * 16 + swz / 64; C = (st & 1) * 32 + (swz % 64) / 2; }
__host__ __device__ __forceinline__ int perm32(int rho) { const int n = rho >> 4, i = rho & 15; return 8 * (i >> 2) + 4 * n + (i & 3); }

struct Unit { int e, pm, pn, row0, nvalid, p0, p1, self; };

__device__ __forceinline__ bool static_order(int nM, int nN, int G, int c, int i, int& pm, int& pn) {
    const int nwg = nM * nN; const long L = (long)i * G + c; if (L >= nwg) return false;
    int wgid = (int)L; { const int q = nwg / NXCD, r = nwg % NXCD, xcd = wgid % NXCD, off = wgid / NXCD; wgid = (xcd < r ? xcd * (q + 1) : r * (q + 1) + (xcd - r) * q) + off; }
    const int nig = WGM * nN, gid = wgid / nig, fm = gid * WGM, gsz = (nM - fm) < WGM ? (nM - fm) : WGM;
    pm = fm + ((wgid % nig) % gsz); pn = (wgid % nig) / gsz; return true;
}

template <class Prob, class Epi, bool ALIGN_EPI>
__device__ __forceinline__ void gemm_phase(LAS unsigned char* lds, const Prob& P, const Epi& E) {
    int tid_ = threadIdx.x; asm volatile("" : "+v"(tid_));
    const int tid = tid_, wid = __builtin_amdgcn_readfirstlane(tid >> 6), lane = tid & 63, wr = wid >> 2, wc = wid & 3, fr = lane & 15, fq = lane >> 4;
    const int K = P.K, nt = K / BK;
    int Rr[2], Cc[2];
    unsigned voffA[2][2], voffB[2], nvoffA[2][2];
#pragma unroll
    for (int i = 0; i < 2; ++i) { stage_rc(tid * 16 + i * 8192, Rr[i], Cc[i]); const int Rb = Epi::PERM ? ((Rr[i] & ~31) + perm32(Rr[i] & 31)) : Rr[i];
        voffB[i] = (unsigned)(Rb * P.ldb + Cc[i]) * 2u;
        voffA[0][i] = (unsigned)(Rr[i] * P.lda + Cc[i]) * 2u; voffA[1][i] = (unsigned)((Rr[i] + HALF) * P.lda + Cc[i]) * 2u; }
    const size_t kstep = (size_t)(BK * 2);
    const size_t hstepB = (size_t)HALF * P.ldb * 2;
    const unsigned ldsw = (unsigned)wid * 1024u;
    const int aoff = lds_byte(wr * 64 + fr, fq * 8), boff = lds_byte(wc * 32 + fr, fq * 8);
#define PG8_SA(b, h) (((b) * 2 + (h)) * HTB)
#define PG8_SB(b, h) ((4 + (b) * 2 + (h)) * HTB)
#define PG8_STAGE(bufoff, gbase, voff) do { _Pragma("unroll") for (int _i = 0; _i < 2; ++_i) \
        __builtin_amdgcn_global_load_lds((const unsigned*)((const char*)(gbase) + (voff)[_i]), (LAS unsigned*)(lds + (bufoff) + ldsw + _i * 8192), 16, 0, 0); } while (0)
#define PG8_LDA(dst, b, h) do { _Pragma("unroll") for (int m = 0; m < 4; ++m) _Pragma("unroll") for (int k = 0; k < 2; ++k) dst[m][k] = *(const LAS bf16x8*)(lds + PG8_SA(b, h) + aoff + m * 2048 + k * 1024); } while (0)
#define PG8_LDB(dst, b, h) do { _Pragma("unroll") for (int n = 0; n < 2; ++n) _Pragma("unroll") for (int k = 0; k < 2; ++k) dst[n][k] = *(const LAS bf16x8*)(lds + PG8_SB(b, h) + boff + n * 2048 + k * 1024); } while (0)
#define PG8_MMA(ai, bj, At, Bt) do { __builtin_amdgcn_s_setprio(1); _Pragma("unroll") for (int m = 0; m < 4; ++m) _Pragma("unroll") for (int n = 0; n < 2; ++n) _Pragma("unroll") for (int k = 0; k < 2; ++k) \
        acc[ai][bj][m][n] = __builtin_amdgcn_mfma_f32_16x16x32_bf16(Bt[n][k], At[m][k], acc[ai][bj][m][n], 0, 0, 0); __builtin_amdgcn_s_setprio(0); } while (0)
#define PG8_WAIT_V(n) asm volatile("s_waitcnt vmcnt(" #n ")" ::: "memory")
#define PG8_WAIT_L(n) asm volatile("s_waitcnt lgkmcnt(" #n ")" ::: "memory")
#define PG8_BAR __builtin_amdgcn_s_barrier()
#define PG8_SCHED __builtin_amdgcn_sched_barrier(0)
    Unit cur, nxt; int ui = 0;
    if (!P.next(0, cur)) return;
    f32x4 acc[2][2][4][2];
#pragma unroll
    for (int a = 0; a < 2; ++a)
#pragma unroll
        for (int b = 0; b < 2; ++b)
#pragma unroll
            for (int m = 0; m < 4; ++m)
#pragma unroll
                for (int n = 0; n < 2; ++n) acc[a][b][m][n] = (f32x4){0.f, 0.f, 0.f, 0.f};
    bf16x8 At[4][2], B0[2][2], B1[2][2];
    const char* cA = P.a_base(cur); const char* cB = P.b_base(cur);
    if constexpr (Prob::GATHER) P.a_voff(cur, Rr, Cc, voffA);
    PG8_STAGE(PG8_SB(0, 0), cB, voffB); PG8_STAGE(PG8_SB(0, 1), cB + hstepB, voffB); PG8_STAGE(PG8_SA(0, 0), cA, voffA[0]); PG8_STAGE(PG8_SA(0, 1), cA, voffA[1]);
    if (wr == 1) PG8_BAR;
    PG8_WAIT_V(2); PG8_BAR;
    PG8_STAGE(PG8_SB(1, 0), cB + kstep, voffB); PG8_STAGE(PG8_SA(1, 0), cA + kstep, voffA[0]); PG8_STAGE(PG8_SB(1, 1), cB + hstepB + kstep, voffB);
    PG8_WAIT_V(6); PG8_BAR;
    for (;;) {
        const bool has_next = P.next(ui + 1, nxt);
        const char* nA = has_next ? P.a_base(nxt) : cA; const char* nB = has_next ? P.b_base(nxt) : cB;
        if constexpr (Prob::GATHER) {
            if (has_next) P.a_voff(nxt, Rr, Cc, nvoffA);
            else { nvoffA[0][0] = voffA[0][0]; nvoffA[0][1] = voffA[0][1]; nvoffA[1][0] = voffA[1][0]; nvoffA[1][1] = voffA[1][1]; }
        }
        for (int t = 0; t < nt; t += 2) {
            const bool last = (t == nt - 2);
            const char* a1 = cA + (size_t)(t + 1) * kstep;
            const char* a2 = last ? nA : cA + (size_t)(t + 2) * kstep; const char* b2 = last ? nB : cB + (size_t)(t + 2) * kstep;
            const char* a3 = a2 + kstep; const char* b3 = b2 + kstep;
            PG8_LDB(B0, 0, 0); PG8_LDB(B1, 0, 1); PG8_SCHED; PG8_LDA(At, 0, 0); PG8_STAGE(PG8_SA(1, 1), a1, voffA[1]);
            if constexpr (Prob::GATHER) { if (last) { voffA[0][0] = nvoffA[0][0]; voffA[0][1] = nvoffA[0][1]; voffA[1][0] = nvoffA[1][0]; voffA[1][1] = nvoffA[1][1]; } }
            PG8_WAIT_V(8); PG8_WAIT_L(0); PG8_BAR; PG8_MMA(0, 0, At, B0); PG8_MMA(0, 1, At, B1); PG8_BAR; PG8_SCHED;
            PG8_LDA(At, 0, 1); PG8_STAGE(PG8_SB(0, 0), b2, voffB); PG8_STAGE(PG8_SB(0, 1), b2 + hstepB, voffB); PG8_STAGE(PG8_SA(0, 0), a2, voffA[0]);
            PG8_WAIT_V(8); PG8_WAIT_L(0); PG8_BAR; PG8_MMA(1, 0, At, B0); PG8_MMA(1, 1, At, B1); PG8_BAR; PG8_SCHED;
            PG8_LDB(B0, 1, 0); PG8_LDB(B1, 1, 1); PG8_SCHED; PG8_LDA(At, 1, 0); PG8_STAGE(PG8_SA(0, 1), a2, voffA[1]);
            PG8_WAIT_V(8); PG8_WAIT_L(0); PG8_BAR; PG8_MMA(0, 0, At, B0); PG8_MMA(0, 1, At, B1); PG8_BAR; PG8_SCHED;
            PG8_LDA(At, 1, 1); PG8_STAGE(PG8_SB(1, 0), b3, voffB); PG8_STAGE(PG8_SB(1, 1), b3 + hstepB, voffB); PG8_STAGE(PG8_SA(1, 0), a3, voffA[0]);
            PG8_WAIT_V(8); PG8_WAIT_L(0); PG8_BAR; PG8_MMA(1, 0, At, B0); PG8_MMA(1, 1, At, B1); PG8_BAR; PG8_SCHED;
        }
        if constexpr (ALIGN_EPI) { if (wr == 0) PG8_BAR; }
        if constexpr (Epi::DRAIN_FIRST) __builtin_amdgcn_s_waitcnt(0x0F70);
        E(acc, cur, wr, wc, fr, fq);
        if (!has_next) break;
#pragma unroll
        for (int a = 0; a < 2; ++a)
#pragma unroll
            for (int b = 0; b < 2; ++b)
#pragma unroll
                for (int m = 0; m < 4; ++m)
#pragma unroll
                    for (int n = 0; n < 2; ++n) acc[a][b][m][n] = (f32x4){0.f, 0.f, 0.f, 0.f};
        cur = nxt; cA = nA; cB = nB; ++ui;
        if constexpr (ALIGN_EPI) { if (wr == 1) PG8_BAR; }
    }
    PG8_WAIT_V(0);
    if constexpr (!ALIGN_EPI) { if (wr == 0) PG8_BAR; }
    PG8_BAR;
#undef PG8_SA
#undef PG8_SB
#undef PG8_STAGE
#undef PG8_LDA
#undef PG8_LDB
#undef PG8_MMA
#undef PG8_WAIT_V
#undef PG8_WAIT_L
#undef PG8_BAR
#undef PG8_SCHED
}
}
using pg8::Unit;

struct ProbDense {
    static constexpr bool GATHER = false;
    const bf16_t* A; const bf16_t* Bt; int K, lda, ldb, nM, nN, G, c;
    __device__ __forceinline__ bool next(int i, Unit& u) const { u.e = 0; u.row0 = 0; u.nvalid = 256; return pg8::static_order(nM, nN, G, c, i, u.pm, u.pn); }
    __device__ __forceinline__ const char* a_base(const Unit& u) const { return (const char*)(A + (size_t)u.pm * 256 * lda); }
    __device__ __forceinline__ const char* b_base(const Unit& u) const { return (const char*)(Bt + (size_t)u.pn * 256 * ldb); }
    __device__ __forceinline__ void a_voff(const Unit&, const int*, const int*, unsigned (&)[2][2]) const {}
};
struct ProbWeff {
    static constexpr bool GATHER = false;
    const bf16_t* A; const bf16_t* Bt; int K, lda, ldb, G, c;
    __device__ __forceinline__ bool next(int i, Unit& u) const { const int L = i * G + c; if (L >= 32) return false; u.pm = L & 7; u.e = L >> 3; u.pn = 0; u.row0 = 0; u.nvalid = 256; return true; }
    __device__ __forceinline__ const char* a_base(const Unit& u) const { return (const char*)(A + (size_t)u.pm * 256 * lda + u.e * 256); }
    __device__ __forceinline__ const char* b_base(const Unit& u) const { return (const char*)(Bt + (size_t)u.e * 256 * 256); }
    __device__ __forceinline__ void a_voff(const Unit&, const int*, const int*, unsigned (&)[2][2]) const {}
};
struct EpiBf16 {
    static constexpr bool PERM = true, DRAIN_FIRST = false;
    bf16_t* O; int ldc; const float* scale; int mode;
    __device__ __forceinline__ void operator()(const f32x4 (&acc)[2][2][4][2], const Unit& u, int wr, int wc, int fr, int fq) const {
        const int rb = (mode == 2 ? u.row0 : u.pm * 256) + wr * 64 + fr; const int cb = (mode == 1 ? u.e * 256 : u.pn * 256) + wc * 32 + 8 * fq;
        f32x4 sv[2][2];
#pragma unroll
        for (int bj = 0; bj < 2; ++bj)
#pragma unroll
            for (int n = 0; n < 2; ++n) sv[bj][n] = scale ? *(const f32x4*)(scale + cb + bj * 128 + 4 * n) : (f32x4){1.f, 1.f, 1.f, 1.f};
#pragma unroll
        for (int ai = 0; ai < 2; ++ai)
#pragma unroll
            for (int m = 0; m < 4; ++m) { bf16_t* rowp = O + (size_t)(rb + ai * 128 + m * 16) * ldc + cb;
#pragma unroll
                for (int bj = 0; bj < 2; ++bj) { const f32x4 v0 = acc[ai][bj][m][0] * sv[bj][0], v1 = acc[ai][bj][m][1] * sv[bj][1];
                    u32x4 w; w.x = cvt_pk_bf16(v0[0], v0[1]); w.y = cvt_pk_bf16(v0[2], v0[3]); w.z = cvt_pk_bf16(v1[0], v1[1]); w.w = cvt_pk_bf16(v1[2], v1[3]);
                    *(u32x4*)(rowp + bj * 128) = w; } }
    }
};
struct EpiResF32 {
    static constexpr bool PERM = false, DRAIN_FIRST = true;
    const float* base; float* out; int ldc;
    __device__ __forceinline__ void operator()(const f32x4 (&acc)[2][2][4][2], const Unit& u, int wr, int wc, int fr, int fq) const {
        const int rb = u.pm * 256 + wr * 64 + fr, cb = u.pn * 256 + wc * 32 + 4 * fq;
#pragma unroll
        for (int ai = 0; ai < 2; ++ai) {
            f32x4 bs[4][2][2];
#pragma unroll
            for (int m = 0; m < 4; ++m) { const size_t off = (size_t)(rb + ai * 128 + m * 16) * ldc + cb;
#pragma unroll
                for (int bj = 0; bj < 2; ++bj)
#pragma unroll
                    for (int n = 0; n < 2; ++n) bs[m][bj][n] = *(const f32x4*)(base + off + bj * 128 + n * 16); }
            asm volatile("" ::: "memory");
#pragma unroll
            for (int m = 0; m < 4; ++m) { const size_t off = (size_t)(rb + ai * 128 + m * 16) * ldc + cb;
#pragma unroll
                for (int bj = 0; bj < 2; ++bj)
#pragma unroll
                    for (int n = 0; n < 2; ++n) *(f32x4*)(out + off + bj * 128 + n * 16) = bs[m][bj][n] + acc[ai][bj][m][n]; }
            asm volatile("" ::: "memory");
        }
    }
};
__device__ __forceinline__ float silu_mul(float g, float u) { const float e = __builtin_amdgcn_exp2f(g * -1.44269504089f); return g * __builtin_amdgcn_rcpf(1.0f + e) * u; }
namespace tt { constexpr int MAXRB = 36, STAGE = (MAXRB + 8) * 1024, NST = 3; }
struct Args { const float* in[16]; float* out; unsigned char* ws; };

__device__ __forceinline__ int swz_f(int r) { return ((r >> 1) & 7) ^ (((r >> 2) ^ (r >> 3)) & 1) ^ ((r >> 4) & 1); }
struct CvtTile { const float* src; bf16_t* dst; int ldw, ldt, n0; };
__device__ __forceinline__ CvtTile cvt_decode(int it, const float* w_in, const float* w_out, bf16_t* WIN, bf16_t* WOUT) {
    CvtTile t;
    constexpr int I_IN = 32 * 16;
    if (it < I_IN) { const int kb = it / 16, nb = it % 16; t.src = w_in + (size_t)(64 * kb) * INC + 256 * nb; t.dst = WIN + 64 * kb; t.ldw = INC; t.ldt = D; t.n0 = 256 * nb; return t; }
    const int r = it - I_IN, kb = r / 8, nb = r % 8; t.src = w_out + (size_t)(64 * kb) * D + 256 * nb; t.dst = WOUT + 64 * kb; t.ldw = D; t.ldt = D; t.n0 = 256 * nb;
    return t;
}
constexpr int CVT_NTILES = 32 * 16 + 32 * 8;

namespace tt8 {
using pg8::Unit;
constexpr int MAXRB = tt::MAXRB, STAGE = tt::STAGE, NST = tt::NST;
constexpr float SC_A = 8.0f, SC_B = 32.0f, SC_INV = 1.0f / (SC_A * SC_B);
__device__ __forceinline__ unsigned pack4_fp8(float a, float b, float c, float d) { int v = __builtin_amdgcn_cvt_pk_fp8_f32(a, b, 0, false); v = __builtin_amdgcn_cvt_pk_fp8_f32(c, d, v, true); return (unsigned)v; }
template <class Prob, class Epi>
__device__ __forceinline__ void gemm_phase(LAS unsigned char* lds, const Prob& P, const Epi& E) {
    int tid_ = threadIdx.x; asm volatile("" : "+v"(tid_));
    const int tid = tid_, wid = __builtin_amdgcn_readfirstlane(tid >> 6), lane = tid & 63, fr = lane & 15, fq = lane >> 4, wm = wid >> 1, wn = wid & 1;
    const int nt = P.K / 64;
    const int Rl = lane >> 2, Cb = 16 * ((lane & 3) ^ ((Rl >> 2) & 3));
    const int swr = ((fr >> 2) & 3) << 1, roff0 = fr * 64 + ((fq ^ swr) << 3), roff1 = fr * 64 + (((4 + fq) ^ swr) << 3);
    const int cq = lane & 31, kq = 2 * wid + (lane >> 5);
    int bw; { const int tc0 = 4 * cq, c32 = tc0 & 31, a_ = c32 >> 3, b_ = (c32 >> 2) & 1, rho0 = (tc0 & ~31) + 16 * b_ + 4 * a_;
        bw = (MAXRB + (rho0 >> 4)) * 1024 + (rho0 & 15) * 64 + ((((kq >> 1) ^ (a_ << 1)) & 7) << 3) + 4 * (kq & 1); }
    Unit u;
    for (int ui = 0; P.next(ui, u); ++ui) {
        const int RB = (u.nvalid + 15) >> 4, nblk = (RB - wm + 3) >> 2;
        const char* cA = P.a_base(u);
        const float* lB = P.b_base(u, cq >> 4) + 4 * (cq & 15) + (size_t)(4 * kq) * P.ldw;
        unsigned voffA[5]; int pidx[5];
#pragma unroll
        for (int i = 0; i < 5; ++i) { int p = wid + 8 * i; p = p < RB ? p : RB - 1; pidx[i] = p; voffA[i] = P.a_voff(u, 16 * p + Rl, Cb); }
        f32x4 acc[9][4];
#pragma unroll
        for (int i = 0; i < 9; ++i)
#pragma unroll
            for (int n = 0; n < 4; ++n) acc[i][n] = (f32x4){0.f, 0.f, 0.f, 0.f};
        f32x4 b0[4];
#define TT8_STAGE_A(st, kt) do { LAS unsigned char* sb_ = lds + (st) * STAGE; _Pragma("unroll") for (int i_ = 0; i_ < 5; ++i_) \
            __builtin_amdgcn_global_load_lds((const unsigned*)(cA + (size_t)(kt) * P.a_kstep + voffA[i_]), (LAS unsigned*)(sb_ + pidx[i_] * 1024), 16, 0, 0); } while (0)
#define TT8_LOAD_B(set, kt) do { const float* r_ = lB + (size_t)(kt) * 64 * P.ldw; _Pragma("unroll") for (int j_ = 0; j_ < 4; ++j_) { const float* p_ = r_ + (size_t)j_ * P.ldw; \
            asm volatile("global_load_dwordx4 %0, %1, off" : "=v"(set[j_]) : "v"(p_) : "memory"); } } while (0)
#define TT8_WRITE_B(set, st) do { _Pragma("unroll") for (int c_ = 0; c_ < 4; ++c_) \
            *(LAS unsigned*)(lds + (st) * STAGE + bw + 64 * c_) = pack4_fp8(set[0][c_] * SC_B, set[1][c_] * SC_B, set[2][c_] * SC_B, set[3][c_] * SC_B); } while (0)
#define TT8_WAIT(n, set) asm volatile("s_waitcnt vmcnt(" #n ")" : "+v"(set[0]), "+v"(set[1]), "+v"(set[2]), "+v"(set[3]) :: "memory")
        asm volatile("s_waitcnt vmcnt(0) lgkmcnt(0)" ::: "memory"); __builtin_amdgcn_s_barrier();
        TT8_LOAD_B(b0, 0); TT8_STAGE_A(0, 0);
        TT8_WAIT(5, b0); TT8_WRITE_B(b0, 0);
        TT8_LOAD_B(b0, 1); TT8_STAGE_A(1, 1);
        int st = 0;
#define TT8_AF(dst, g_) do { _Pragma("unroll") for (int i = 0; i < 3; ++i) { dst[i][0] = *(const LAS long*)(sa_ + (4 * (3 * (g_) + i) + wm) * 1024 + roff0); dst[i][1] = *(const LAS long*)(sa_ + (4 * (3 * (g_) + i) + wm) * 1024 + roff1); } } while (0)
#define TT8_MM(src, g_) do { __builtin_amdgcn_s_setprio(1); \
            _Pragma("unroll") for (int i = 0; i < 3; ++i) { if (3 * (g_) + i < nblk) { _Pragma("unroll") for (int ks = 0; ks < 2; ++ks) _Pragma("unroll") for (int nb = 0; nb < 4; ++nb) \
                acc[3 * (g_) + i][nb] = __builtin_amdgcn_mfma_f32_16x16x32_fp8_fp8(bf_[nb][ks], src[i][ks], acc[3 * (g_) + i][nb], 0, 0, 0); } } \
            __builtin_amdgcn_s_setprio(0); } while (0)
#define TT8_STEP(t, SET) do { \
            TT8_WAIT(5, SET); asm volatile("s_waitcnt lgkmcnt(0)" ::: "memory"); __builtin_amdgcn_s_barrier();     \
            int s1_ = st + 1; s1_ = s1_ >= NST ? s1_ - NST : s1_; int s2_ = s1_ + 1; s2_ = s2_ >= NST ? s2_ - NST : s2_; \
            TT8_WRITE_B(SET, s1_); \
            { const int t3_ = (t) + 2 < nt ? (t) + 2 : nt - 1; TT8_LOAD_B(SET, t3_); } \
            { const int t2_ = (t) + 2 < nt ? (t) + 2 : nt - 1; TT8_STAGE_A(s2_, t2_); } \
            const LAS unsigned char* sa_ = lds + st * STAGE; \
            long bf_[4][2]; _Pragma("unroll") for (int nb = 0; nb < 4; ++nb) { bf_[nb][0] = *(const LAS long*)(sa_ + (MAXRB + Prob::bsub(wn, nb)) * 1024 + roff0); bf_[nb][1] = *(const LAS long*)(sa_ + (MAXRB + Prob::bsub(wn, nb)) * 1024 + roff1); } \
            long afa_[3][2], afb_[3][2]; \
            TT8_AF(afa_, 0); TT8_AF(afb_, 1);        \
            TT8_MM(afa_, 0); \
            TT8_AF(afa_, 2); \
            TT8_MM(afb_, 1); \
            TT8_MM(afa_, 2); \
            st = s1_; } while (0)
        for (int t = 0; t < nt; ++t) { TT8_STEP(t, b0); }
        TT8_WAIT(0, b0);
        E(acc, u, RB, wm, wn, fr, fq);
#undef TT8_STAGE_A
#undef TT8_LOAD_B
#undef TT8_WRITE_B
#undef TT8_WAIT
#undef TT8_STEP
#undef TT8_AF
#undef TT8_MM
    }
    asm volatile("s_waitcnt vmcnt(0) lgkmcnt(0)" ::: "memory"); __builtin_amdgcn_s_barrier();
}
}
struct ProbTT8a {
    const unsigned char* A; const float* Wg; const float* Wu; const int* list; int K, lda, ldw; const volatile LAS int* ul; int nunits; static constexpr size_t a_kstep = 64;
    __device__ __forceinline__ bool next(int i, Unit& u) const { if (i >= nunits) return false; u.e = __builtin_amdgcn_readfirstlane(ul[8 * i]); u.pn = __builtin_amdgcn_readfirstlane(ul[8 * i + 1]);
        u.pm = __builtin_amdgcn_readfirstlane(ul[8 * i + 2]); u.row0 = __builtin_amdgcn_readfirstlane(ul[8 * i + 3]); u.nvalid = __builtin_amdgcn_readfirstlane(ul[8 * i + 4]); return true; }
    __device__ __forceinline__ const char* a_base(const Unit&) const { return (const char*)A; }
    __device__ __forceinline__ const float* b_base(const Unit& u, int par) const { return (par ? Wu : Wg) + (size_t)u.e * K * ldw + 64 * u.pn; }
    __device__ __forceinline__ unsigned a_voff(const Unit& u, int r, int cb) const { const int last = u.nvalid - 1; r = r < last ? r : last; const int tok = list[(size_t)u.e * T + u.pm * 576 + r]; return (unsigned)(tok * lda + cb); }
    static __device__ __forceinline__ int bsub(int wn, int nb) { return (nb >> 1) * 4 + 2 * wn + (nb & 1); }
};
struct EpiTT8Swiglu {
    unsigned char* O; int ldc;
    __device__ __forceinline__ void operator()(const f32x4 (&acc)[9][4], const Unit& u, int RB, int wm, int wn, int fr, int fq) const {
        unsigned char* base = O + ((size_t)u.pn * MAXSLOT + (size_t)(u.row0 + fr)) * 64 + 32 * wn + 8 * fq;
#pragma unroll
        for (int i = 0; i < 9; ++i) if (4 * i + wm < RB) {
            const f32x4 g0 = acc[i][0] * tt8::SC_INV, g1 = acc[i][1] * tt8::SC_INV, u0 = acc[i][2] * (tt8::SC_INV * tt8::SC_A), u1 = acc[i][3] * (tt8::SC_INV * tt8::SC_A);
#define SMC(g_, u_) __builtin_amdgcn_fmed3f(silu_mul(g_, u_), -440.0f, 440.0f)
            u32x2 w; w.x = tt8::pack4_fp8(SMC(g0[0], u0[0]), SMC(g0[1], u0[1]), SMC(g0[2], u0[2]), SMC(g0[3], u0[3]));
            w.y = tt8::pack4_fp8(SMC(g1[0], u1[0]), SMC(g1[1], u1[1]), SMC(g1[2], u1[2]), SMC(g1[3], u1[3]));
#undef SMC
            *(u32x2*)(base + (size_t)(16 * (4 * i + wm)) * 64) = w; }
    }
};
struct ProbTT8b {
    const unsigned char* A; const float* W; int K, lda, ldw; const volatile LAS int* ul; int nunits; static constexpr size_t a_kstep = (size_t)MAXSLOT * 64;
    __device__ __forceinline__ bool next(int i, Unit& u) const { if (i >= nunits) return false; u.e = __builtin_amdgcn_readfirstlane(ul[8 * i]); u.pn = __builtin_amdgcn_readfirstlane(ul[8 * i + 1]);
        u.pm = __builtin_amdgcn_readfirstlane(ul[8 * i + 2]); u.row0 = __builtin_amdgcn_readfirstlane(ul[8 * i + 3]); u.nvalid = __builtin_amdgcn_readfirstlane(ul[8 * i + 4]); return true; }
    __device__ __forceinline__ const char* a_base(const Unit& u) const { return (const char*)(A + (size_t)u.row0 * 64); }
    __device__ __forceinline__ const float* b_base(const Unit& u, int par) const { return W + (size_t)u.e * K * ldw + 128 * u.pn + 64 * par; }
    __device__ __forceinline__ unsigned a_voff(const Unit& u, int r, int cb) const { const int last = u.nvalid - 1; r = r < last ? r : last; return (unsigned)(r * 64 + cb); }
    static __device__ __forceinline__ int bsub(int wn, int nb) { return 4 * wn + nb; }
};
struct EpiTT8Y {
    bf16_t* O; int ldc;
    __device__ __forceinline__ void operator()(const f32x4 (&acc)[9][4], const Unit& u, int RB, int wm, int wn, int fr, int fq) const {
        bf16_t* base = O + (size_t)(u.row0 + fr) * ldc + 128 * u.pn + 64 * wn + 8 * fq;
#pragma unroll
        for (int i = 0; i < 9; ++i) if (4 * i + wm < RB) {
#pragma unroll
            for (int h = 0; h < 2; ++h) { const f32x4 a0 = acc[i][2 * h] * tt8::SC_INV, a1 = acc[i][2 * h + 1] * tt8::SC_INV;
                u32x4 w; w.x = cvt_pk_bf16(a0[0], a0[1]); w.y = cvt_pk_bf16(a0[2], a0[3]); w.z = cvt_pk_bf16(a1[0], a1[1]); w.w = cvt_pk_bf16(a1[2], a1[3]);
                *(u32x4*)(base + (size_t)(16 * (4 * i + wm)) * ldc + 32 * h) = w; } }
    }
};

__device__ __forceinline__ int build_tt_units(volatile LAS int* misc, unsigned* ctl, int vcu, int G) {
    volatile LAS int* cnt = misc + MISC_ETAB; volatile LAS int* nmt = cnt + 32; volatile LAS int* pst = nmt + 32;
    volatile LAS int* ul = misc + MISC_NUNIT + 8;
    int tid = threadIdx.x; asm volatile("" : "+v"(tid));
    __syncthreads();
    if (tid < 32) { const int c = (int)__hip_atomic_load(ctl + CW_ECNT + 64 * tid, RLX_AGENT); cnt[tid] = c; nmt[tid] = (c + 255) >> 8; }
    __syncthreads();
    if (tid == 0) {
        volatile LAS int* ubt = pst + 33;
        int p = 0, q = 0; for (int e = 0; e < 32; ++e) { pst[e] = p; ubt[e] = q; p += nmt[e] * 256; q += 16 * ((cnt[e] + 575) / 576); } pst[32] = p; ubt[32] = q;
        int n = 0, e = 0;
        for (int L = vcu; L < q; L += G) {
            while (L >= ubt[e + 1]) ++e;
            const int r = L - ubt[e], rc = r >> 4, pn = r & 15, nv = cnt[e] - 576 * rc;
            ul[8 * n] = e; ul[8 * n + 1] = pn; ul[8 * n + 2] = rc; ul[8 * n + 3] = pst[e] + 576 * rc; ul[8 * n + 4] = nv < 576 ? nv : 576;
            ul[8 * n + 5] = (pn > 0 && (L - pn) / G == L / G) ? 16 * (L - pn) : -1; ul[8 * n + 6] = -1; ul[8 * n + 7] = 16 * L;
            ++n;
        }
        misc[MISC_NUNIT] = n;
    }
    __syncthreads();
    return misc[MISC_NUNIT];
}

__global__ void __launch_bounds__(NTHREADS, 2) fwd_kernel(Args args) {
    extern __shared__ __attribute__((aligned(16))) unsigned char lds_raw[];
    LAS unsigned char* lds = (LAS unsigned char*)lds_raw;
    volatile LAS int* misc = (volatile LAS int*)(lds + MISC_OFF);
    const int tid = threadIdx.x, lane = tid & 63, wave = __builtin_amdgcn_readfirstlane(tid >> 6);
    const int G = gridDim.x, bx = blockIdx.x;
    const int vcu = (G % 8 == 0) ? (bx % 8) * (G / 8) + bx / 8 : bx;
    const int gw = vcu * NWAVES + wave, NGW = G * NWAVES;

    unsigned char* ws = args.ws;
    unsigned* ctl = (unsigned*)(ws + WS_CTL);
    const float* x = args.in[0]; const float* g1 = args.in[1]; const float* w_in = args.in[2]; const float* w_pool = args.in[3]; const float* pool_scale = args.in[4];
    const float* conv_w = args.in[5]; const float* w_out = args.in[6]; const float* g2 = args.in[7]; const float* w_rg = args.in[8]; const float* b_rg = args.in[9];
    const float* w_re = args.in[10]; const float* b_re = args.in[11]; const float* w_gate = args.in[12]; const float* w_up = args.in[13]; const float* w_down = args.in[14];
    const float* g3 = args.in[15];
    float* out = args.out;
    bf16_t* WRTH = (bf16_t*)(ws + WS_WRT + 512 * 1024); bf16_t* WRTL = (bf16_t*)(ws + WS_WRT + 768 * 1024); bf16_t* WPOOL = (bf16_t*)(ws + WS_WPOOL); int* LIST = (int*)(ws + WS_LIST); i32x4* ASG = (i32x4*)(ws + WS_ASG); f32x2* ASW = (f32x2*)(ws + WS_ASW);
    bf16_t* WIN = (bf16_t*)(ws + WS_WIN); bf16_t* WOUT = (bf16_t*)(ws + WS_WOUT); bf16_t* XN = (bf16_t*)(ws + WS_XN); bf16_t* PROJ = (bf16_t*)(ws + WS_PROJ);
    bf16_t* MIXED = (bf16_t*)(ws + WS_MIXED); bf16_t* MIXO = (bf16_t*)(ws + WS_X1); bf16_t* HID = (bf16_t*)(ws + WS_HID);
    bf16_t* Y = (bf16_t*)(ws + WS_Y);

    for (int u = tid; u < 1024; u += NTHREADS) misc[u] = 0;
    __syncthreads();
    XcdBarrier bar = xcd_barrier_post(ctl + CW_BAR, (volatile LAS unsigned*)(misc + MISC_BAR));

    for (int rep_ = 0; rep_ < REP_P0; ++rep_) {
    {
        {
            int it = vcu;
            f32x4 v[8];
            CvtTile cur = cvt_decode(it < CVT_NTILES ? it : 0, w_in, w_out, WIN, WOUT);
            if (it < CVT_NTILES) {
#pragma unroll
                for (int j = 0; j < 8; ++j) v[j] = __builtin_nontemporal_load((const f32x4*)(cur.src + (size_t)(8 * wave + j) * cur.ldw) + lane);
            }
            int buf = 0;
            while (it < CVT_NTILES) {
                LAS unsigned char* tb = lds + buf * 32768;
                u32x4 p[4];
#pragma unroll
                for (int c = 0; c < 4; ++c) { p[c].x = cvt_pk_bf16(v[0][c], v[1][c]); p[c].y = cvt_pk_bf16(v[2][c], v[3][c]); p[c].z = cvt_pk_bf16(v[4][c], v[5][c]); p[c].w = cvt_pk_bf16(v[6][c], v[7][c]); }
#pragma unroll
                for (int c = 0; c < 4; ++c) { const int r = 4 * lane + c; *(LAS u32x4*)(tb + r * 128 + ((wave ^ swz_f(r)) << 4)) = p[c]; }
                const int nit = it + G; const bool has_next = nit < CVT_NTILES;
                CvtTile nx = cvt_decode(has_next ? nit : 0, w_in, w_out, WIN, WOUT);
                if (has_next) {
#pragma unroll
                    for (int j = 0; j < 8; ++j) v[j] = __builtin_nontemporal_load((const f32x4*)(nx.src + (size_t)(8 * wave + j) * nx.ldw) + lane);
                }
                __syncthreads();
#pragma unroll
                for (int i = 0; i < 4; ++i) { const int r = (tid >> 3) + 64 * i, ch = tid & 7; const u32x4 o = *(const LAS u32x4*)(tb + r * 128 + ((ch ^ swz_f(r)) << 4));
                    *(u32x4*)(cur.dst + (size_t)(cur.n0 + r) * cur.ldt + 8 * ch) = o; }
                buf ^= 1; it = nit; cur = nx;
            }
            __syncthreads();
        }
        for (int i = bx * NTHREADS + tid; i < 4 * 65536; i += G * NTHREADS) { const int g = i >> 16, d = i & 255; WPOOL[i] = (bf16_t)f2bf(w_pool[i] * pool_scale[g * 256 + d]); }
        for (int i = bx * NTHREADS + tid; i < 48 * D; i += G * NTHREADS) { const int c = i / D, k = i % D; const float w = c < 4 ? w_rg[k * 4 + c] * g2[k] : (c < NRC ? w_re[k * 32 + (c - 4)] * g2[k] : 0.f);
            const unsigned hi = f2bf(w); const float wl = w - __builtin_bit_cast(float, hi << 16); WRTH[i] = (bf16_t)hi; WRTL[i] = (bf16_t)f2bf(wl); }
        for (int m = gw; m < T; m += NGW) {
            const f32x4* xr = (const f32x4*)(x + (size_t)m * D) + lane; f32x4 v[8]; float s = 0.f;
#pragma unroll
            for (int j = 0; j < 8; ++j) { v[j] = xr[64 * j]; s += (v[j].x * v[j].x + v[j].y * v[j].y) + (v[j].z * v[j].z + v[j].w * v[j].w); }
            const float rstd = 1.0f / sqrtf(wave_sum(s) * (1.0f / D) + EPS);
            u32x2* o = (u32x2*)(XN + (size_t)m * D) + lane;
#pragma unroll
            for (int j = 0; j < 8; ++j) { const f32x4 g = ((const f32x4*)g1)[64 * j + lane]; u32x2 w; w.x = pk2(v[j].x * rstd * g.x, v[j].y * rstd * g.y); w.y = pk2(v[j].z * rstd * g.z, v[j].w * rstd * g.w); o[64 * j] = w; }
        }
    }
    xcd_barrier(bar);
    }

    for (int rep_ = 0; rep_ < REP_P1; ++rep_) {
    {
        ProbDense P{XN, WIN, D, D, D, T / 256, INC / 256, G, bx};
        EpiBf16 E{PROJ, INC, nullptr, 0};
        pg8::gemm_phase<ProbDense, EpiBf16, true>(lds, P, E);
    }
    xcd_barrier(bar);
    }

    for (int rep_ = 0; rep_ < REP_P2; ++rep_) {
    {
        if (rep_ == 0) { ProbWeff P{WOUT, WPOOL, 256, D, 256, G, vcu}; EpiBf16 E{WOUT, D, nullptr, 1}; pg8::gemm_phase<ProbWeff, EpiBf16, false>(lds, P, E); }
        bf16_t* const POOLDST = MIXED; constexpr int POOLLD = D;
        for (int it = gw; it < 2048; it += NGW) {
            const int part = it >> 10, q = it & 1023, chunk = q >> 1, slab = q & 1, r0 = chunk * 16, c0 = slab * 512 + lane * 8;
#define BF8(v, f) { f[0] = bflo(v.x); f[1] = bfhi(v.x); f[2] = bflo(v.y); f[3] = bfhi(v.y); f[4] = bflo(v.z); f[5] = bfhi(v.z); f[6] = bflo(v.w); f[7] = bfhi(v.w); }
            if (part == 0) {
                const int gi = c0 >> 8, w = 2 << gi;
                float s[8];
#pragma unroll
                for (int j = 0; j < 8; ++j) s[j] = 0.f;
                { u32x4 iv[16];
#pragma unroll
                  for (int i = 0; i < 16; ++i) { const int rr = r0 - 1 - i; iv[i] = *(const u32x4*)(PROJ + (size_t)(rr < 0 ? 0 : rr) * INC + c0); }
#pragma unroll
                  for (int i = 0; i < 16; ++i) { const bool ok = (i < w) && (r0 - 1 - i >= 0); float f[8]; BF8(iv[i], f);
#pragma unroll
                      for (int j = 0; j < 8; ++j) s[j] += ok ? f[j] : 0.f; } }
#pragma unroll 1
                for (int tb = 0; tb < 2; ++tb) {
                    const int t0 = r0 + 8 * tb; u32x4 nv[8], ov[8];
#pragma unroll
                    for (int k = 0; k < 8; ++k) { nv[k] = *(const u32x4*)(PROJ + (size_t)(t0 + k) * INC + c0); const int ro = t0 + k - w; ov[k] = *(const u32x4*)(PROJ + (size_t)(ro < 0 ? 0 : ro) * INC + c0); }
#pragma unroll
                    for (int k = 0; k < 8; ++k) { const int t = t0 + k; float un[8], uo[8]; BF8(nv[k], un); BF8(ov[k], uo); const bool ok = t - w >= 0;
#pragma unroll
                        for (int j = 0; j < 8; ++j) s[j] += un[j] - (ok ? uo[j] : 0.f);
                        const int cn = (t + 1) < w ? (t + 1) : w; const float inv = 1.0f / (float)cn;
                        u32x4 p; p.x = pk2(s[0] * inv - un[0], s[1] * inv - un[1]); p.y = pk2(s[2] * inv - un[2], s[3] * inv - un[3]);
                        p.z = pk2(s[4] * inv - un[4], s[5] * inv - un[5]); p.w = pk2(s[6] * inv - un[6], s[7] * inv - un[7]);
                        *(u32x4*)(POOLDST + (size_t)t * POOLLD + c0) = p; }
                }
            } else {
                float cw[8][3];
#pragma unroll
                for (int j = 0; j < 8; ++j) { cw[j][0] = conv_w[(c0 + j) * 3 + 0]; cw[j][1] = conv_w[(c0 + j) * 3 + 1]; cw[j][2] = conv_w[(c0 + j) * 3 + 2]; }
                float z2[8], z1[8];
                { const int ra = r0 >= 2 ? r0 - 2 : 0, rb = r0 >= 1 ? r0 - 1 : 0;
                  const u32x4 ca = *(const u32x4*)(PROJ + (size_t)ra * INC + MIXA + MIXB + c0), va = *(const u32x4*)(PROJ + (size_t)ra * INC + MIXA + 2 * MIXB + c0);
                  const u32x4 cb = *(const u32x4*)(PROJ + (size_t)rb * INC + MIXA + MIXB + c0), vb = *(const u32x4*)(PROJ + (size_t)rb * INC + MIXA + 2 * MIXB + c0);
                  float fa[8], fb[8], fc[8], fd[8]; BF8(ca, fa); BF8(va, fb); BF8(cb, fc); BF8(vb, fd);
#pragma unroll
                  for (int j = 0; j < 8; ++j) { z2[j] = r0 >= 2 ? fa[j] * fb[j] : 0.f; z1[j] = r0 >= 1 ? fc[j] * fd[j] : 0.f; } }
#pragma unroll 1
                for (int tb = 0; tb < 2; ++tb) {
                    const int t0 = r0 + 8 * tb; u32x4 bbv[8], ccv[8], vvv[8];
#pragma unroll
                    for (int k = 0; k < 8; ++k) { const bf16_t* pr = PROJ + (size_t)(t0 + k) * INC + c0; bbv[k] = *(const u32x4*)(pr + MIXA); ccv[k] = *(const u32x4*)(pr + MIXA + MIXB); vvv[k] = *(const u32x4*)(pr + MIXA + 2 * MIXB); }
#pragma unroll
                    for (int k = 0; k < 8; ++k) { float bg[8], cg[8], vg[8]; BF8(bbv[k], bg); BF8(ccv[k], cg); BF8(vvv[k], vg); float yv[8];
#pragma unroll
                        for (int j = 0; j < 8; ++j) { const float z0 = cg[j] * vg[j]; yv[j] = bg[j] * (z2[j] * cw[j][0] + z1[j] * cw[j][1] + z0 * cw[j][2]); z2[j] = z1[j]; z1[j] = z0; }
                        u32x4 p; p.x = pk2(yv[0], yv[1]); p.y = pk2(yv[2], yv[3]); p.z = pk2(yv[4], yv[5]); p.w = pk2(yv[6], yv[7]);
                        *(u32x4*)(MIXED + (size_t)(t0 + k) * D + MIXA + c0) = p; }
                }
            }
#undef BF8
        }
    }
    xcd_barrier(bar);
    }

    for (int rep_ = 0; rep_ < REP_P4; ++rep_) {
    {
        ProbDense P{MIXED, WOUT, D, D, D, T / 256, D / 256, G, bx};
        EpiBf16 E{MIXO, D, nullptr, 0};
        pg8::gemm_phase<ProbDense, EpiBf16, false>(lds, P, E);
    }
    xcd_barrier(bar);
    }

    for (int rep_ = 0; rep_ < REP_P5; ++rep_) {
    {
        bf16_t* H2 = XN;
        for (int rb = vcu; rb < T / 32; rb += G) {
            const int row0 = rb * 32 + wave * 4;
            float rstd[4]; float mylog[4];
            {
                LAS float* red = (LAS float*)lds;
                LAS float* ssp = red + 8 * 6 * 64 * 4;
                LAS float* lgs = ssp + 8 * 2 * 64;
                LAS float* rsd = lgs + 32 * 48;
                const int rowb = rb * 32, fr = lane & 15, fq = lane >> 4;
                f32x4 acc[2][3];
#pragma unroll
                for (int a = 0; a < 2; ++a)
#pragma unroll
                    for (int c = 0; c < 3; ++c) acc[a][c] = (f32x4){0.f, 0.f, 0.f, 0.f};
                float ssl[2] = {0.f, 0.f};
#pragma unroll 2
                for (int ks = 0; ks < 8; ++ks) {
                    const int k0 = 256 * wave + 32 * ks + 8 * fq;
                    bf16x8 bh[3], bl[3];
#pragma unroll
                    for (int c = 0; c < 3; ++c) { bh[c] = *(const bf16x8*)(WRTH + (size_t)(16 * c + fr) * D + k0); bl[c] = *(const bf16x8*)(WRTL + (size_t)(16 * c + fr) * D + k0); }
#pragma unroll
                    for (int a = 0; a < 2; ++a) { const size_t ro = (size_t)(rowb + 16 * a + fr) * D + k0;
                        const f32x4 xa = *(const f32x4*)(x + ro), xb = *(const f32x4*)(x + ro + 4); const u32x4 mo = *(const u32x4*)(MIXO + ro);
                        const float v[8] = {xa.x + bflo(mo.x), xa.y + bfhi(mo.x), xa.z + bflo(mo.y), xa.w + bfhi(mo.y), xb.x + bflo(mo.z), xb.y + bfhi(mo.z), xb.z + bflo(mo.w), xb.w + bfhi(mo.w)};
                        u32x4 hp, lp;
#pragma unroll
                        for (int q = 0; q < 4; ++q) { const unsigned h = cvt_pk_bf16(v[2 * q], v[2 * q + 1]); hp[q] = h; lp[q] = cvt_pk_bf16(v[2 * q] - bflo(h), v[2 * q + 1] - bfhi(h));
                            ssl[a] += v[2 * q] * v[2 * q] + v[2 * q + 1] * v[2 * q + 1]; }
                        const bf16x8 ah = __builtin_bit_cast(bf16x8, hp), al = __builtin_bit_cast(bf16x8, lp);
#pragma unroll
                        for (int c = 0; c < 3; ++c) { acc[a][c] = __builtin_amdgcn_mfma_f32_16x16x32_bf16(ah, bh[c], acc[a][c], 0, 0, 0); acc[a][c] = __builtin_amdgcn_mfma_f32_16x16x32_bf16(ah, bl[c], acc[a][c], 0, 0, 0);
                            acc[a][c] = __builtin_amdgcn_mfma_f32_16x16x32_bf16(al, bh[c], acc[a][c], 0, 0, 0); } }
                }
#pragma unroll
                for (int a = 0; a < 2; ++a) { ssp[(wave * 2 + a) * 64 + lane] = ssl[a];
#pragma unroll
                    for (int c = 0; c < 3; ++c) *(LAS f32x4*)(red + ((wave * 6 + a * 3 + c) * 64 + lane) * 4) = acc[a][c]; }
                __syncthreads();
#pragma unroll
                for (int i = 0; i < 3; ++i) { const int o = tid + 512 * i, r = o / 48, c = o - 48 * r, a = r >> 4, rr = r & 15, cb = c >> 4, cc = c & 15, ln = cc + 16 * (rr >> 2), reg = rr & 3; float s = 0.f;
#pragma unroll
                    for (int w = 0; w < 8; ++w) s += red[((w * 6 + a * 3 + cb) * 64 + ln) * 4 + reg];
                    lgs[o] = s; }
                if (tid < 32) { const int a = tid >> 4, rr = tid & 15; float s = 0.f;
#pragma unroll
                    for (int w = 0; w < 8; ++w)
#pragma unroll
                        for (int q = 0; q < 4; ++q) s += ssp[(w * 2 + a) * 64 + rr + 16 * q];
                    rsd[tid] = 1.0f / sqrtf(s * (1.0f / D) + EPS); }
                __syncthreads();
#pragma unroll
                for (int r = 0; r < 4; ++r) { rstd[r] = rsd[4 * wave + r]; mylog[r] = (lane < 48 ? lgs[(4 * wave + r) * 48 + lane] : 0.f) * rstd[r]; }
            }
#pragma unroll
            for (int j = 0; j < 8; ++j) { const f32x4 g = ((const f32x4*)g2)[64 * j + lane];
#pragma unroll
                for (int r = 0; r < 4; ++r) { const u32x2 mo = *((const u32x2*)(MIXO + (size_t)(row0 + r) * D + 256 * j) + lane); f32x4 xv = *((const f32x4*)(x + (size_t)(row0 + r) * D + 256 * j) + lane);
                    xv.x += bflo(mo.x); xv.y += bfhi(mo.x); xv.z += bflo(mo.y); xv.w += bfhi(mo.y);
                    const float sc = rstd[r] * tt8::SC_A;
                    ((unsigned*)((unsigned char*)H2 + (size_t)(row0 + r) * D))[64 * j + lane] = tt8::pack4_fp8(xv.x * sc * g.x, xv.y * sc * g.y, xv.z * sc * g.z, xv.w * sc * g.w);
                } }
            const float bias = lane < 4 ? b_rg[lane] : (lane < NRC ? b_re[lane - 4] : 0.f);
#pragma unroll
            for (int r = 0; r < 4; ++r) {
                const float lg = mylog[r] + bias;
                float g[4];
#pragma unroll
                for (int i = 0; i < 4; ++i) g[i] = __shfl(lg, i);
                int grp = 0; float gm = g[0];
#pragma unroll
                for (int i = 1; i < 4; ++i) if (g[i] > gm) { gm = g[i]; grp = i; }
                float gs = 0.f;
#pragma unroll
                for (int i = 0; i < 4; ++i) gs += expf(g[i] - gm);
                const float g_w = 1.0f / gs;
                float el[8];
#pragma unroll
                for (int i = 0; i < 8; ++i) el[i] = __shfl(lg, 4 + grp * 8 + i);
                int i0 = 0; float m0 = el[0];
#pragma unroll
                for (int i = 1; i < 8; ++i) if (el[i] > m0) { m0 = el[i]; i0 = i; }
                int i1 = -1; float m1 = -3.0e38f;
#pragma unroll
                for (int i = 0; i < 8; ++i) if (i != i0 && el[i] > m1) { m1 = el[i]; i1 = i; }
                const float p1 = expf(m1 - m0);
                const float w0 = g_w / (1.0f + p1), w1 = g_w * p1 / (1.0f + p1);
                if (lane == 0) { const int a = (wave * 4 + r) * 2; misc[256 + a] = grp * 8 + i0; misc[256 + a + 1] = grp * 8 + i1;
                    misc[384 + a] = __builtin_bit_cast(int, w0); misc[384 + a + 1] = __builtin_bit_cast(int, w1); }
            }
            __syncthreads();
            if (wave == 0) {
                const int a = lane, tok = rb * 32 + (a >> 1), e = misc[256 + a];
                unsigned long long mym = 0ull;
#pragma unroll 1
                for (int ee = 0; ee < NE; ++ee) { const unsigned long long m = __ballot(e == ee); if (e == ee) mym = m; }
                const int rank = __popcll(mym & ((1ull << lane) - 1ull)), cntl = __popcll(mym), leader = __ffsll((long long)mym) - 1;
                int base = 0;
                if (rank == 0) base = (int)__hip_atomic_fetch_add(ctl + CW_ECNT + 64 * e + (rep_ == REP_P5 - 1 ? 0 : 32), (unsigned)cntl, RLX_AGENT);
                base = __shfl(base, leader);
                const int pos = base + rank;
                LIST[(size_t)e * T + pos] = tok;
                ((int*)ASG)[(size_t)tok * 4 + (a & 1) * 2] = e; ((int*)ASG)[(size_t)tok * 4 + (a & 1) * 2 + 1] = pos;
                ((int*)ASW)[(size_t)tok * 2 + (a & 1)] = misc[384 + a];
            }
            __syncthreads();
        }
    }
    xcd_barrier(bar);
    }

    for (int rep_ = 0; rep_ < REP_P67; ++rep_) {
    {
        const int nu = build_tt_units(misc, ctl, vcu, G);
        ProbTT8a P{(const unsigned char*)XN, w_gate, w_up, LIST, D, D, DE, misc + MISC_NUNIT + 8, nu};
        EpiTT8Swiglu E{(unsigned char*)HID, DE};
        for (int r6_ = 0; r6_ < REP_P6; ++r6_) { if (r6_) xcd_barrier(bar); tt8::gemm_phase<ProbTT8a, EpiTT8Swiglu>(lds, P, E); }
    }
    xcd_barrier(bar);

    {
        const int nu = build_tt_units(misc, ctl, vcu, G);
        ProbTT8b P{(const unsigned char*)HID, w_down, DE, DE, D, misc + MISC_NUNIT + 8, nu};
        EpiTT8Y E{Y, D};
        for (int r7_ = 0; r7_ < REP_P7; ++r7_) { if (r7_) xcd_barrier(bar); tt8::gemm_phase<ProbTT8b, EpiTT8Y>(lds, P, E); }
    }
    xcd_barrier(bar);

    }
    for (int rep_ = 0; rep_ < REP_P8; ++rep_) {
    if (rep_) xcd_barrier(bar);
    {
        volatile LAS int* pst = misc + MISC_ETAB + 64;
        for (int m = gw; m < T; m += NGW) {
            const i32x4 as = ASG[m]; const f32x2 aw = ASW[m];
            const int s0 = pst[as.x] + as.y, s1 = pst[as.z] + as.w;
            const f32x4* xr = (const f32x4*)(x + (size_t)m * D) + lane; const u32x2* mo_ = (const u32x2*)(MIXO + (size_t)m * D) + lane; const u32x2* y0 = (const u32x2*)(Y + (size_t)s0 * D) + lane; const u32x2* y1 = (const u32x2*)(Y + (size_t)s1 * D) + lane;
            f32x4 v[8]; float s = 0.f;
#pragma unroll
            for (int j = 0; j < 8; ++j) { f32x4 xx = xr[64 * j]; const u32x2 a = y0[64 * j], b = y1[64 * j], mo = mo_[64 * j];
                xx.x += bflo(mo.x); xx.y += bfhi(mo.x); xx.z += bflo(mo.y); xx.w += bfhi(mo.y);
                v[j].x = xx.x + aw.x * bflo(a.x) + aw.y * bflo(b.x); v[j].y = xx.y + aw.x * bfhi(a.x) + aw.y * bfhi(b.x);
                v[j].z = xx.z + aw.x * bflo(a.y) + aw.y * bflo(b.y); v[j].w = xx.w + aw.x * bfhi(a.y) + aw.y * bfhi(b.y);
                s += (v[j].x * v[j].x + v[j].y * v[j].y) + (v[j].z * v[j].z + v[j].w * v[j].w); }
            const float rstd = 1.0f / sqrtf(wave_sum(s) * (1.0f / D) + EPS);
            f32x4* o = (f32x4*)(out + (size_t)m * D) + lane;
#pragma unroll
            for (int j = 0; j < 8; ++j) { const f32x4 g = ((const f32x4*)g3)[64 * j + lane]; o[64 * j] = (f32x4){v[j].x * rstd * g.x, v[j].y * rstd * g.y, v[j].z * rstd * g.z, v[j].w * rstd * g.w}; }
        }
    }
    }
}

extern "C" void kernel_launch(void* const* d_in, const int* in_sizes, int n_in, void* d_out, int out_size, void* d_ws, size_t ws_size, hipStream_t stream) {
    static int grid = 0;
    if (grid == 0) {
        if (n_in != 16 || in_sizes[0] != T * D || out_size != T * D || ws_size < WS_END) { fprintf(stderr, "kernel_launch: unexpected shapes (n_in %d, in0 %d, out %d, ws %zu); nothing launched\n", n_in, n_in > 0 ? in_sizes[0] : -1, out_size, ws_size); grid = -1; return; }
        int dev = 0, cus = 0, per_cu = 0;
        if (hipGetDevice(&dev) != hipSuccess || hipDeviceGetAttribute(&cus, hipDeviceAttributeMultiprocessorCount, dev) != hipSuccess) { fprintf(stderr, "kernel_launch: device query failed\n"); grid = -1; return; }
        if (hipFuncSetAttribute((const void*)fwd_kernel, hipFuncAttributeMaxDynamicSharedMemorySize, LDS_BYTES) != hipSuccess) { fprintf(stderr, "kernel_launch: hipFuncSetAttribute failed\n"); grid = -1; return; }
        if (hipOccupancyMaxActiveBlocksPerMultiprocessor(&per_cu, (const void*)fwd_kernel, NTHREADS, LDS_BYTES) != hipSuccess || per_cu < 1) { fprintf(stderr, "kernel_launch: occupancy query says %d blocks per CU; nothing launched\n", per_cu); (void)hipGetLastError(); grid = -1; return; }
        grid = cus;
    }
    if (grid < 0) return;
    if (hipMemsetAsync((char*)d_ws + WS_CTL, 0, CTL_BYTES, stream) != hipSuccess) { fprintf(stderr, "kernel_launch: memset failed\n"); return; }
    Args a{};
    for (int i = 0; i < 16; ++i) a.in[i] = (const float*)d_in[i];
    a.out = (float*)d_out; a.ws = (unsigned char*)d_ws;
    void* kargs[] = {&a};
    hipError_t le = hipLaunchCooperativeKernel((const void*)fwd_kernel, dim3(grid), dim3(NTHREADS), kargs, LDS_BYTES, stream);
    if (le != hipSuccess) fprintf(stderr, "kernel_launch: cooperative launch failed: %s (grid %d)\n", hipGetErrorString(le), grid);
}
```

```cpp
#include <hip/hip_runtime.h>
#include <cstdio>
#include <cstdint>

#define LAS __attribute__((address_space(3)))
#define GAS __attribute__((address_space(1)))
typedef unsigned short bf16_t;
typedef short bf16x8 __attribute__((ext_vector_type(8)));
typedef float f32x4 __attribute__((ext_vector_type(4)));
typedef float f32x2 __attribute__((ext_vector_type(2)));
typedef unsigned u32x4 __attribute__((ext_vector_type(4)));
typedef unsigned u32x2 __attribute__((ext_vector_type(2)));
typedef int i32x4 __attribute__((ext_vector_type(4)));

#ifndef REP_P0
#define REP_P0 1
#endif
#ifndef REP_P1
#define REP_P1 1
#endif
#ifndef REP_P2
#define REP_P2 1
#endif
#ifndef REP_P3
#define REP_P3 1
#endif
#ifndef REP_P4
#define REP_P4 1
#endif
#ifndef REP_P5
#define REP_P5 1
#endif
#ifndef REP_P6
#define REP_P6 1
#endif
#ifndef REP_P7
#define REP_P7 1
#endif
#ifndef REP_P67
#define REP_P67 1
#endif
#ifndef REP_P8
#define REP_P8 1
#endif
constexpr int T = 8192, D = 2048, INC = 4096, MIXA = 1024, MIXB = 1024, NE = 32, DE = 1024, NGRP = 4, EPG = 8;
constexpr int POOLCH = 256, NRC = 36;
constexpr float EPS = 1e-6f;
constexpr int MAXSLOT = 24576;
constexpr int NWAVES = 8, NTHREADS = 512;

constexpr size_t MiB = 1u << 20;
constexpr size_t WS_CTL = 0, CTL_BYTES = 64 * 1024;
constexpr size_t WS_WRT = 1 * MiB;
constexpr size_t WS_WPOOL = 2 * MiB;
constexpr size_t WS_LIST = 3 * MiB;
constexpr size_t WS_ASG = 4 * MiB;
constexpr size_t WS_ASW = 5 * MiB;
constexpr size_t WS_WIN = 8 * MiB;
constexpr size_t WS_WOUT = 24 * MiB;
constexpr size_t WS_XN = 32 * MiB;
constexpr size_t WS_PROJ = 64 * MiB;
constexpr size_t WS_MIXED = 144 * MiB;
constexpr size_t WS_X1 = 176 * MiB;
constexpr size_t WS_HID = 240 * MiB;
constexpr size_t WS_Y = 288 * MiB;
constexpr size_t WS_END = 384 * MiB;
constexpr int CW_ECNT = 1024;
constexpr int CW_BAR = 4096;

constexpr int RING_BYTES = 135168;
constexpr int MISC_OFF = RING_BYTES;
constexpr int MISC_BAR = 0;
constexpr int MISC_ETAB = 16;
constexpr int MISC_NUNIT = 160;
constexpr int LDS_BYTES = 147456;

#define LDS_WAIT() asm volatile("s_waitcnt lgkmcnt(0)" ::: "memory")
#define VM_WAIT() asm volatile("s_waitcnt vmcnt(0)" ::: "memory")
#define RLX_AGENT __ATOMIC_RELAXED, __HIP_MEMORY_SCOPE_AGENT

__device__ __forceinline__ unsigned f2bf(float f) { unsigned u = __builtin_bit_cast(unsigned, f); return (u + 0x7fffu + ((u >> 16) & 1u)) >> 16; }
__device__ __forceinline__ unsigned pk2(float lo, float hi) { return f2bf(lo) | (f2bf(hi) << 16); }
__device__ __forceinline__ unsigned cvt_pk_bf16(float lo, float hi) { unsigned r; asm volatile("v_cvt_pk_bf16_f32 %0, %1, %2" : "=v"(r) : "v"(lo), "v"(hi)); return r; }
__device__ __forceinline__ float bflo(unsigned w) { return __builtin_bit_cast(float, w << 16); }
__device__ __forceinline__ float bfhi(unsigned w) { return __builtin_bit_cast(float, w & 0xffff0000u); }
__device__ __forceinline__ float wave_sum(float v) {
#pragma unroll
    for (int o = 1; o < 64; o <<= 1) v += __shfl_xor(v, o);
    return v;
}

__device__ __forceinline__ float wave_sum_dpp(float v) {
    v += __builtin_bit_cast(float, __builtin_amdgcn_update_dpp(0, __builtin_bit_cast(int, v), 0xB1, 0xF, 0xF, false));
    v += __builtin_bit_cast(float, __builtin_amdgcn_update_dpp(0, __builtin_bit_cast(int, v), 0x4E, 0xF, 0xF, false));
    v += __builtin_bit_cast(float, __builtin_amdgcn_update_dpp(0, __builtin_bit_cast(int, v), 0x141, 0xF, 0xF, false));
    v += __builtin_bit_cast(float, __builtin_amdgcn_update_dpp(0, __builtin_bit_cast(int, v), 0x140, 0xF, 0xF, false));
    v += __builtin_bit_cast(float, __builtin_amdgcn_update_dpp(0, __builtin_bit_cast(int, v), 0x142, 0xA, 0xF, false));
    v += __builtin_bit_cast(float, __builtin_amdgcn_update_dpp(0, __builtin_bit_cast(int, v), 0x143, 0xC, 0xF, false));
    return __builtin_bit_cast(float, __builtin_amdgcn_readlane(__builtin_bit_cast(int, v), 63));
}

#define XB_TMO      128
#define XB_XCNT(j)  (256  + 64 * (j))
#define XB_XSUB(j)  (1280 + 64 * (j))
#define XB_XGEN(j)  (2304 + 64 * (j))
#define XB_TOP      3328
#define XB_TOPGEN   3392
#define XCD_BAR_WORDS 3456
#define XB_SPIN_CAP (1u << 18)
__device__ __forceinline__ unsigned xb_ld(unsigned* p)              { return __hip_atomic_load(p, __ATOMIC_RELAXED, __HIP_MEMORY_SCOPE_AGENT); }
__device__ __forceinline__ unsigned xb_add(unsigned* p, unsigned v) { return __hip_atomic_fetch_add(p, v, __ATOMIC_RELAXED, __HIP_MEMORY_SCOPE_AGENT); }
__device__ __forceinline__ unsigned xb_xcc_id() { return (unsigned)__builtin_amdgcn_s_getreg((3 << 11) | 20) & 0xFu; }
#define XB_SPIN(cond, bar) do { unsigned _sp = 0; while (cond) { __builtin_amdgcn_s_sleep(1); \
    if ((++_sp & 255u) == 0u) { if (xb_ld(&(bar)[XB_TMO])) break; if (_sp > XB_SPIN_CAP) { atomicAdd(&(bar)[XB_TMO], 1u); break; } } } } while (0)
struct XcdBarrier { unsigned* bar; unsigned x; volatile LAS unsigned* st; };
__device__ __forceinline__ XcdBarrier xcd_barrier_post(unsigned* bar, volatile LAS unsigned* st) {
    XcdBarrier b; b.bar = bar; b.x = xb_xcc_id(); b.st = st;
    if (threadIdx.x == 0) (void)xb_add(&bar[XB_XCNT(b.x)], 1u);
    return b;
}
__device__ __forceinline__ void xcd_barrier_complete(unsigned* bar, unsigned x, unsigned& nloc, unsigned& nx) {
    const unsigned G = gridDim.x * gridDim.y * gridDim.z;
    unsigned sum, cnt, mine, sp = 0u;
    for (;;) {
        sum = 0u; cnt = 0u; mine = 0u;
#pragma unroll
        for (unsigned j = 0; j < 16; ++j) { const unsigned c = xb_ld(&bar[XB_XCNT(j)]); sum += c; cnt += (c > 0u) ? 1u : 0u; mine = (j == x) ? c : mine; }
        if (sum == G) break;
        __builtin_amdgcn_s_sleep(1);
        if ((++sp & 255u) == 0u) { if (xb_ld(&bar[XB_TMO])) break; if (sp > XB_SPIN_CAP) { atomicAdd(&bar[XB_TMO], 1u); break; } }
    }
    nloc = mine > 0u ? mine : 1u; nx = cnt > 0u ? cnt : 1u;
}
__device__ __forceinline__ void xcd_barrier(const XcdBarrier& b) {
    asm volatile("s_waitcnt vmcnt(0)" ::: "memory");
    __syncthreads();
    if (threadIdx.x == 0) {
        unsigned* bar = b.bar;
        __builtin_amdgcn_s_waitcnt(0);
        unsigned nloc = b.st[0], nx = b.st[1];
        if (nloc == 0u) { xcd_barrier_complete(bar, b.x, nloc, nx); b.st[0] = nloc; b.st[1] = nx; }
        const unsigned old = xb_add(&bar[XB_XSUB(b.x)], 1u);
        const unsigned gen = old / nloc;
        if (old + 1u == (gen + 1u) * nloc) {
            __builtin_amdgcn_fence(__ATOMIC_RELEASE, "agent");
            asm volatile("s_waitcnt vmcnt(0)" ::: "memory");
            (void)xb_add(&bar[XB_TOP], 1u);
        }
        XB_SPIN(xb_ld(&bar[XB_TOP]) < (gen + 1u) * nx, bar);
        __builtin_amdgcn_fence(__ATOMIC_ACQUIRE, "agent");
        asm volatile("s_waitcnt vmcnt(0)" ::: "memory");
    }
    __syncthreads();
}

namespace pg8 {
constexpr int BM = 256, BK = 64, HALF = 128, HTB = HALF * BK * 2, NXCD = 8, WGM = 8;
__host__ __device__ __forceinline__ int lds_byte(int r, int c) { const int st = (r >> 4) * 2 + (c >> 5), rr = r & 15, cc = c & 31, ob = rr * 64 + cc * 2; return st * 1024 + (ob ^ (((ob >> 9) & 1) << 5)); }
__host__ __device__ __forceinline__ void stage_rc(int b, int& R, int& C) { const int st = b / 1024, sb = b % 1024, swz = sb ^ (((sb >> 9) & 1) << 5); R = (st >> 1) * 16 + swz / 64; C = (st & 1) * 32 + (swz % 64) / 2; }
__host__ __device__ __forceinline__ int perm32(int rho) { const int n = rho >> 4, i = rho & 15; return 8 * (i >> 2) + 4 * n + (i & 3); }

struct Unit { int e, pm, pn, row0, nvalid, p0, p1, self; };

__device__ __forceinline__ bool static_order(int nM, int nN, int G, int c, int i, int& pm, int& pn) {
    const int nwg = nM * nN; const long L = (long)i * G + c; if (L >= nwg) return false;
    int wgid = (int)L; { const int q = nwg / NXCD, r = nwg % NXCD, xcd = wgid % NXCD, off = wgid / NXCD; wgid = (xcd < r ? xcd * (q + 1) : r * (q + 1) + (xcd - r) * q) + off; }
    const int nig = WGM * nN, gid = wgid / nig, fm = gid * WGM, gsz = (nM - fm) < WGM ? (nM - fm) : WGM;
    pm = fm + ((wgid % nig) % gsz); pn = (wgid % nig) / gsz; return true;
}

template <class Prob, class Epi, bool ALIGN_EPI>
__device__ __forceinline__ void gemm_phase(LAS unsigned char* lds, const Prob& P, const Epi& E) {
    int tid_ = threadIdx.x; asm volatile("" : "+v"(tid_));
    const int tid = tid_, wid = __builtin_amdgcn_readfirstlane(tid >> 6), lane = tid & 63, wr = wid >> 2, wc = wid & 3, fr = lane & 15, fq = lane >> 4;
    const int K = P.K, nt = K / BK;
    int Rr[2], Cc[2];
    unsigned voffA[2][2], voffB[2], nvoffA[2][2];
#pragma unroll
    for (int i = 0; i < 2; ++i) { stage_rc(tid * 16 + i * 8192, Rr[i], Cc[i]); const int Rb = Epi::PERM ? ((Rr[i] & ~31) + perm32(Rr[i] & 31)) : Rr[i];
        voffB[i] = (unsigned)(Rb * P.ldb + Cc[i]) * 2u;
        voffA[0][i] = (unsigned)(Rr[i] * P.lda + Cc[i]) * 2u; voffA[1][i] = (unsigned)((Rr[i] + HALF) * P.lda + Cc[i]) * 2u; }
    const size_t kstep = (size_t)(BK * 2);
    const size_t hstepB = (size_t)HALF * P.ldb * 2;
    const unsigned ldsw = (unsigned)wid * 1024u;
    const int aoff = lds_byte(wr * 64 + fr, fq * 8), boff = lds_byte(wc * 32 + fr, fq * 8);
#define PG8_SA(b, h) (((b) * 2 + (h)) * HTB)
#define PG8_SB(b, h) ((4 + (b) * 2 + (h)) * HTB)
#define PG8_STAGE(bufoff, gbase, voff) do { _Pragma("unroll") for (int _i = 0; _i < 2; ++_i) \
        __builtin_amdgcn_global_load_lds((const unsigned*)((const char*)(gbase) + (voff)[_i]), (LAS unsigned*)(lds + (bufoff) + ldsw + _i * 8192), 16, 0, 0); } while (0)
#define PG8_LDA(dst, b, h) do { _Pragma("unroll") for (int m = 0; m < 4; ++m) _Pragma("unroll") for (int k = 0; k < 2; ++k) dst[m][k] = *(const LAS bf16x8*)(lds + PG8_SA(b, h) + aoff + m * 2048 + k * 1024); } while (0)
#define PG8_LDB(dst, b, h) do { _Pragma("unroll") for (int n = 0; n < 2; ++n) _Pragma("unroll") for (int k = 0; k < 2; ++k) dst[n][k] = *(const LAS bf16x8*)(lds + PG8_SB(b, h) + boff + n * 2048 + k * 1024); } while (0)
#define PG8_MMA(ai, bj, At, Bt) do { __builtin_amdgcn_s_setprio(1); _Pragma("unroll") for (int m = 0; m < 4; ++m) _Pragma("unroll") for (int n = 0; n < 2; ++n) _Pragma("unroll") for (int k = 0; k < 2; ++k) \
        acc[ai][bj][m][n] = __builtin_amdgcn_mfma_f32_16x16x32_bf16(Bt[n][k], At[m][k], acc[ai][bj][m][n], 0, 0, 0); __builtin_amdgcn_s_setprio(0); } while (0)
#define PG8_WAIT_V(n) asm volatile("s_waitcnt vmcnt(" #n ")" ::: "memory")
#define PG8_WAIT_L(n) asm volatile("s_waitcnt lgkmcnt(" #n ")" ::: "memory")
#define PG8_BAR __builtin_amdgcn_s_barrier()
#define PG8_SCHED __builtin_amdgcn_sched_barrier(0)
    Unit cur, nxt; int ui = 0;
    if (!P.next(0, cur)) return;
    f32x4 acc[2][2][4][2];
#pragma unroll
    for (int a = 0; a < 2; ++a)
#pragma unroll
        for (int b = 0; b < 2; ++b)
#pragma unroll
            for (int m = 0; m < 4; ++m)
#pragma unroll
                for (int n = 0; n < 2; ++n) acc[a][b][m][n] = (f32x4){0.f, 0.f, 0.f, 0.f};
    bf16x8 At[4][2], B0[2][2], B1[2][2];
    const char* cA = P.a_base(cur); const char* cB = P.b_base(cur);
    if constexpr (Prob::GATHER) P.a_voff(cur, Rr, Cc, voffA);
    PG8_STAGE(PG8_SB(0, 0), cB, voffB); PG8_STAGE(PG8_SB(0, 1), cB + hstepB, voffB); PG8_STAGE(PG8_SA(0, 0), cA, voffA[0]); PG8_STAGE(PG8_SA(0, 1), cA, voffA[1]);
    if (wr == 1) PG8_BAR;
    PG8_WAIT_V(2); PG8_BAR;
    PG8_STAGE(PG8_SB(1, 0), cB + kstep, voffB); PG8_STAGE(PG8_SA(1, 0), cA + kstep, voffA[0]); PG8_STAGE(PG8_SB(1, 1), cB + hstepB + kstep, voffB);
    PG8_WAIT_V(6); PG8_BAR;
    for (;;) {
        const bool has_next = P.next(ui + 1, nxt);
        const char* nA = has_next ? P.a_base(nxt) : cA; const char* nB = has_next ? P.b_base(nxt) : cB;
        if constexpr (Prob::GATHER) {
            if (has_next) P.a_voff(nxt, Rr, Cc, nvoffA);
            else { nvoffA[0][0] = voffA[0][0]; nvoffA[0][1] = voffA[0][1]; nvoffA[1][0] = voffA[1][0]; nvoffA[1][1] = voffA[1][1]; }
        }
        for (int t = 0; t < nt; t += 2) {
            const bool last = (t == nt - 2);
            const char* a1 = cA + (size_t)(t + 1) * kstep;
            const char* a2 = last ? nA : cA + (size_t)(t + 2) * kstep; const char* b2 = last ? nB : cB + (size_t)(t + 2) * kstep;
            const char* a3 = a2 + kstep; const char* b3 = b2 + kstep;
            PG8_LDB(B0, 0, 0); PG8_LDB(B1, 0, 1); PG8_SCHED; PG8_LDA(At, 0, 0); PG8_STAGE(PG8_SA(1, 1), a1, voffA[1]);
            if constexpr (Prob::GATHER) { if (last) { voffA[0][0] = nvoffA[0][0]; voffA[0][1] = nvoffA[0][1]; voffA[1][0] = nvoffA[1][0]; voffA[1][1] = nvoffA[1][1]; } }
            PG8_WAIT_V(8); PG8_WAIT_L(0); PG8_BAR; PG8_MMA(0, 0, At, B0); PG8_MMA(0, 1, At, B1); PG8_BAR; PG8_SCHED;
            PG8_LDA(At, 0, 1); PG8_STAGE(PG8_SB(0, 0), b2, voffB); PG8_STAGE(PG8_SB(0, 1), b2 + hstepB, voffB); PG8_STAGE(PG8_SA(0, 0), a2, voffA[0]);
            PG8_WAIT_V(8); PG8_WAIT_L(0); PG8_BAR; PG8_MMA(1, 0, At, B0); PG8_MMA(1, 1, At, B1); PG8_BAR; PG8_SCHED;
            PG8_LDB(B0, 1, 0); PG8_LDB(B1, 1, 1); PG8_SCHED; PG8_LDA(At, 1, 0); PG8_STAGE(PG8_SA(0, 1), a2, voffA[1]);
            PG8_WAIT_V(8); PG8_WAIT_L(0); PG8_BAR; PG8_MMA(0, 0, At, B0); PG8_MMA(0, 1, At, B1); PG8_BAR; PG8_SCHED;
            PG8_LDA(At, 1, 1); PG8_STAGE(PG8_SB(1, 0), b3, voffB); PG8_STAGE(PG8_SB(1, 1), b3 + hstepB, voffB); PG8_STAGE(PG8_SA(1, 0), a3, voffA[0]);
            PG8_WAIT_V(8); PG8_WAIT_L(0); PG8_BAR; PG8_MMA(1, 0, At, B0); PG8_MMA(1, 1, At, B1); PG8_BAR; PG8_SCHED;
        }
        if constexpr (ALIGN_EPI) { if (wr == 0) PG8_BAR; }
        if constexpr (Epi::DRAIN_FIRST) __builtin_amdgcn_s_waitcnt(0x0F70);
        E(acc, cur, wr, wc, fr, fq);
        if (!has_next) break;
#pragma unroll
        for (int a = 0; a < 2; ++a)
#pragma unroll
            for (int b = 0; b < 2; ++b)
#pragma unroll
                for (int m = 0; m < 4; ++m)
#pragma unroll
                    for (int n = 0; n < 2; ++n) acc[a][b][m][n] = (f32x4){0.f, 0.f, 0.f, 0.f};
        cur = nxt; cA = nA; cB = nB; ++ui;
        if constexpr (ALIGN_EPI) { if (wr == 1) PG8_BAR; }
    }
    PG8_WAIT_V(0);
    if constexpr (!ALIGN_EPI) { if (wr == 0) PG8_BAR; }
    PG8_BAR;
#undef PG8_SA
#undef PG8_SB
#undef PG8_STAGE
#undef PG8_LDA
#undef PG8_LDB
#undef PG8_MMA
#undef PG8_WAIT_V
#undef PG8_WAIT_L
#undef PG8_BAR
#undef PG8_SCHED
}
}
using pg8::Unit;

struct ProbDense {
    static constexpr bool GATHER = false;
    const bf16_t* A; const bf16_t* Bt; int K, lda, ldb, nM, nN, G, c;
    __device__ __forceinline__ bool next(int i, Unit& u) const { u.e = 0; u.row0 = 0; u.nvalid = 256; return pg8::static_order(nM, nN, G, c, i, u.pm, u.pn); }
    __device__ __forceinline__ const char* a_base(const Unit& u) const { return (const char*)(A + (size_t)u.pm * 256 * lda); }
    __device__ __forceinline__ const char* b_base(const Unit& u) const { return (const char*)(Bt + (size_t)u.pn * 256 * ldb); }
    __device__ __forceinline__ void a_voff(const Unit&, const int*, const int*, unsigned (&)[2][2]) const {}
};
struct ProbWeff {
    static constexpr bool GATHER = false;
    const bf16_t* A; const bf16_t* Bt; int K, lda, ldb, G, c;
    __device__ __forceinline__ bool next(int i, Unit& u) const { const int L = i * G + c; if (L >= 32) return false; u.pm = L & 7; u.e = L >> 3; u.pn = 0; u.row0 = 0; u.nvalid = 256; return true; }
    __device__ __forceinline__ const char* a_base(const Unit& u) const { return (const char*)(A + (size_t)u.pm * 256 * lda + u.e * 256); }
    __device__ __forceinline__ const char* b_base(const Unit& u) const { return (const char*)(Bt + (size_t)u.e * 256 * 256); }
    __device__ __forceinline__ void a_voff(const Unit&, const int*, const int*, unsigned (&)[2][2]) const {}
};
struct EpiBf16 {
    static constexpr bool PERM = true, DRAIN_FIRST = false;
    bf16_t* O; int ldc; const float* scale; int mode;
    __device__ __forceinline__ void operator()(const f32x4 (&acc)[2][2][4][2], const Unit& u, int wr, int wc, int fr, int fq) const {
        const int rb = (mode == 2 ? u.row0 : u.pm * 256) + wr * 64 + fr; const int cb = (mode == 1 ? u.e * 256 : u.pn * 256) + wc * 32 + 8 * fq;
        f32x4 sv[2][2];
#pragma unroll
        for (int bj = 0; bj < 2; ++bj)
#pragma unroll
            for (int n = 0; n < 2; ++n) sv[bj][n] = scale ? *(const f32x4*)(scale + cb + bj * 128 + 4 * n) : (f32x4){1.f, 1.f, 1.f, 1.f};
#pragma unroll
        for (int ai = 0; ai < 2; ++ai)
#pragma unroll
            for (int m = 0; m < 4; ++m) { bf16_t* rowp = O + (size_t)(rb + ai * 128 + m * 16) * ldc + cb;
#pragma unroll
                for (int bj = 0; bj < 2; ++bj) { const f32x4 v0 = acc[ai][bj][m][0] * sv[bj][0], v1 = acc[ai][bj][m][1] * sv[bj][1];
                    u32x4 w; w.x = cvt_pk_bf16(v0[0], v0[1]); w.y = cvt_pk_bf16(v0[2], v0[3]); w.z = cvt_pk_bf16(v1[0], v1[1]); w.w = cvt_pk_bf16(v1[2], v1[3]);
                    *(u32x4*)(rowp + bj * 128) = w; } }
    }
};
struct EpiResF32 {
    static constexpr bool PERM = false, DRAIN_FIRST = true;
    const float* base; float* out; int ldc;
    __device__ __forceinline__ void operator()(const f32x4 (&acc)[2][2][4][2], const Unit& u, int wr, int wc, int fr, int fq) const {
        const int rb = u.pm * 256 + wr * 64 + fr, cb = u.pn * 256 + wc * 32 + 4 * fq;
#pragma unroll
        for (int ai = 0; ai < 2; ++ai) {
            f32x4 bs[4][2][2];
#pragma unroll
            for (int m = 0; m < 4; ++m) { const size_t off = (size_t)(rb + ai * 128 + m * 16) * ldc + cb;
#pragma unroll
                for (int bj = 0; bj < 2; ++bj)
#pragma unroll
                    for (int n = 0; n < 2; ++n) bs[m][bj][n] = *(const f32x4*)(base + off + bj * 128 + n * 16); }
            asm volatile("" ::: "memory");
#pragma unroll
            for (int m = 0; m < 4; ++m) { const size_t off = (size_t)(rb + ai * 128 + m * 16) * ldc + cb;
#pragma unroll
                for (int bj = 0; bj < 2; ++bj)
#pragma unroll
                    for (int n = 0; n < 2; ++n) *(f32x4*)(out + off + bj * 128 + n * 16) = bs[m][bj][n] + acc[ai][bj][m][n]; }
            asm volatile("" ::: "memory");
        }
    }
};
__device__ __forceinline__ float silu_mul(float g, float u) { const float e = __builtin_amdgcn_exp2f(g * -1.44269504089f); return g * __builtin_amdgcn_rcpf(1.0f + e) * u; }
namespace tt { constexpr int MAXRB = 36, STAGE = (MAXRB + 8) * 1024, NST = 3; }
struct Args { const float* in[16]; float* out; unsigned char* ws; };

__device__ __forceinline__ int swz_f(int r) { return ((r >> 1) & 7) ^ (((r >> 2) ^ (r >> 3)) & 1) ^ ((r >> 4) & 1); }
struct CvtTile { const float* src; bf16_t* dst; int ldw, ldt, n0; };
__device__ __forceinline__ CvtTile cvt_decode(int it, const float* w_in, const float* w_out, bf16_t* WIN, bf16_t* WOUT) {
    CvtTile t;
    constexpr int I_IN = 32 * 16;
    if (it < I_IN) { const int kb = it / 16, nb = it % 16; t.src = w_in + (size_t)(64 * kb) * INC + 256 * nb; t.dst = WIN + 64 * kb; t.ldw = INC; t.ldt = D; t.n0 = 256 * nb; return t; }
    const int r = it - I_IN, kb = r / 8, nb = r % 8; t.src = w_out + (size_t)(64 * kb) * D + 256 * nb; t.dst = WOUT + 64 * kb; t.ldw = D; t.ldt = D; t.n0 = 256 * nb;
    return t;
}
constexpr int CVT_NTILES = 32 * 16 + 32 * 8;

namespace tt8 {
using pg8::Unit;
constexpr int MAXRB = tt::MAXRB, STAGE = tt::STAGE, NST = tt::NST;
constexpr float SC_A = 8.0f, SC_B = 32.0f, SC_INV = 1.0f / (SC_A * SC_B);
__device__ __forceinline__ unsigned pack4_fp8(float a, float b, float c, float d) { int v = __builtin_amdgcn_cvt_pk_fp8_f32(a, b, 0, false); v = __builtin_amdgcn_cvt_pk_fp8_f32(c, d, v, true); return (unsigned)v; }
template <class Prob, class Epi>
__device__ __forceinline__ void gemm_phase(LAS unsigned char* lds, const Prob& P, const Epi& E) {
    int tid_ = threadIdx.x; asm volatile("" : "+v"(tid_));
    const int tid = tid_, wid = __builtin_amdgcn_readfirstlane(tid >> 6), lane = tid & 63, fr = lane & 15, fq = lane >> 4, wm = wid >> 1, wn = wid & 1;
    const int nt = P.K / 64;
    const int Rl = lane >> 2, Cb = 16 * ((lane & 3) ^ ((Rl >> 2) & 3));
    const int swr = ((fr >> 2) & 3) << 1, roff0 = fr * 64 + ((fq ^ swr) << 3), roff1 = fr * 64 + (((4 + fq) ^ swr) << 3);
    const int cq = lane & 31, kq = 2 * wid + (lane >> 5);
    int bw; { const int tc0 = 4 * cq, c32 = tc0 & 31, a_ = c32 >> 3, b_ = (c32 >> 2) & 1, rho0 = (tc0 & ~31) + 16 * b_ + 4 * a_;
        bw = (MAXRB + (rho0 >> 4)) * 1024 + (rho0 & 15) * 64 + ((((kq >> 1) ^ (a_ << 1)) & 7) << 3) + 4 * (kq & 1); }
    Unit u;
    for (int ui = 0; P.next(ui, u); ++ui) {
        const int RB = (u.nvalid + 15) >> 4, nblk = (RB - wm + 3) >> 2;
        const char* cA = P.a_base(u);
        const float* lB = P.b_base(u, cq >> 4) + 4 * (cq & 15) + (size_t)(4 * kq) * P.ldw;
        unsigned voffA[5]; int pidx[5];
#pragma unroll
        for (int i = 0; i < 5; ++i) { int p = wid + 8 * i; p = p < RB ? p : RB - 1; pidx[i] = p; voffA[i] = P.a_voff(u, 16 * p + Rl, Cb); }
        f32x4 acc[9][4];
#pragma unroll
        for (int i = 0; i < 9; ++i)
#pragma unroll
            for (int n = 0; n < 4; ++n) acc[i][n] = (f32x4){0.f, 0.f, 0.f, 0.f};
        f32x4 b0[4];
#define TT8_STAGE_A(st, kt) do { LAS unsigned char* sb_ = lds + (st) * STAGE; _Pragma("unroll") for (int i_ = 0; i_ < 5; ++i_) \
            __builtin_amdgcn_global_load_lds((const unsigned*)(cA + (size_t)(kt) * P.a_kstep + voffA[i_]), (LAS unsigned*)(sb_ + pidx[i_] * 1024), 16, 0, 0); } while (0)
#define TT8_LOAD_B(set, kt) do { const float* r_ = lB + (size_t)(kt) * 64 * P.ldw; _Pragma("unroll") for (int j_ = 0; j_ < 4; ++j_) { const float* p_ = r_ + (size_t)j_ * P.ldw; \
            asm volatile("global_load_dwordx4 %0, %1, off" : "=v"(set[j_]) : "v"(p_) : "memory"); } } while (0)
#define TT8_WRITE_B(set, st) do { _Pragma("unroll") for (int c_ = 0; c_ < 4; ++c_) \
            *(LAS unsigned*)(lds + (st) * STAGE + bw + 64 * c_) = pack4_fp8(set[0][c_] * SC_B, set[1][c_] * SC_B, set[2][c_] * SC_B, set[3][c_] * SC_B); } while (0)
#define TT8_WAIT(n, set) asm volatile("s_waitcnt vmcnt(" #n ")" : "+v"(set[0]), "+v"(set[1]), "+v"(set[2]), "+v"(set[3]) :: "memory")
        asm volatile("s_waitcnt vmcnt(0) lgkmcnt(0)" ::: "memory"); __builtin_amdgcn_s_barrier();
        TT8_LOAD_B(b0, 0); TT8_STAGE_A(0, 0);
        TT8_WAIT(5, b0); TT8_WRITE_B(b0, 0);
        TT8_LOAD_B(b0, 1); TT8_STAGE_A(1, 1);
        int st = 0;
#define TT8_AF(dst, g_) do { _Pragma("unroll") for (int i = 0; i < 3; ++i) { dst[i][0] = *(const LAS long*)(sa_ + (4 * (3 * (g_) + i) + wm) * 1024 + roff0); dst[i][1] = *(const LAS long*)(sa_ + (4 * (3 * (g_) + i) + wm) * 1024 + roff1); } } while (0)
#define TT8_MM(src, g_) do { __builtin_amdgcn_s_setprio(1); \
            _Pragma("unroll") for (int i = 0; i < 3; ++i) { if (3 * (g_) + i < nblk) { _Pragma("unroll") for (int ks = 0; ks < 2; ++ks) _Pragma("unroll") for (int nb = 0; nb < 4; ++nb) \
                acc[3 * (g_) + i][nb] = __builtin_amdgcn_mfma_f32_16x16x32_fp8_fp8(bf_[nb][ks], src[i][ks], acc[3 * (g_) + i][nb], 0, 0, 0); } } \
            __builtin_amdgcn_s_setprio(0); } while (0)
#define TT8_STEP(t, SET) do { \
            TT8_WAIT(5, SET); asm volatile("s_waitcnt lgkmcnt(0)" ::: "memory"); __builtin_amdgcn_s_barrier();     \
            int s1_ = st + 1; s1_ = s1_ >= NST ? s1_ - NST : s1_; int s2_ = s1_ + 1; s2_ = s2_ >= NST ? s2_ - NST : s2_; \
            TT8_WRITE_B(SET, s1_); \
            { const int t3_ = (t) + 2 < nt ? (t) + 2 : nt - 1; TT8_LOAD_B(SET, t3_); } \
            { const int t2_ = (t) + 2 < nt ? (t) + 2 : nt - 1; TT8_STAGE_A(s2_, t2_); } \
            const LAS unsigned char* sa_ = lds + st * STAGE; \
            long bf_[4][2]; _Pragma("unroll") for (int nb = 0; nb < 4; ++nb) { bf_[nb][0] = *(const LAS long*)(sa_ + (MAXRB + Prob::bsub(wn, nb)) * 1024 + roff0); bf_[nb][1] = *(const LAS long*)(sa_ + (MAXRB + Prob::bsub(wn, nb)) * 1024 + roff1); } \
            long afa_[3][2], afb_[3][2]; \
            TT8_AF(afa_, 0); TT8_AF(afb_, 1);        \
            TT8_MM(afa_, 0); \
            TT8_AF(afa_, 2); \
            TT8_MM(afb_, 1); \
            TT8_MM(afa_, 2); \
            st = s1_; } while (0)
        for (int t = 0; t < nt; ++t) { TT8_STEP(t, b0); }
        TT8_WAIT(0, b0);
        E(acc, u, RB, wm, wn, fr, fq);
#undef TT8_STAGE_A
#undef TT8_LOAD_B
#undef TT8_WRITE_B
#undef TT8_WAIT
#undef TT8_STEP
#undef TT8_AF
#undef TT8_MM
    }
    asm volatile("s_waitcnt vmcnt(0) lgkmcnt(0)" ::: "memory"); __builtin_amdgcn_s_barrier();
}
}
struct ProbTT8a {
    const unsigned char* A; const float* Wg; const float* Wu; const int* list; int K, lda, ldw; const volatile LAS int* ul; int nunits; static constexpr size_t a_kstep = 64;
    __device__ __forceinline__ bool next(int i, Unit& u) const { if (i >= nunits) return false; u.e = __builtin_amdgcn_readfirstlane(ul[8 * i]); u.pn = __builtin_amdgcn_readfirstlane(ul[8 * i + 1]);
        u.pm = __builtin_amdgcn_readfirstlane(ul[8 * i + 2]); u.row0 = __builtin_amdgcn_readfirstlane(ul[8 * i + 3]); u.nvalid = __builtin_amdgcn_readfirstlane(ul[8 * i + 4]); return true; }
    __device__ __forceinline__ const char* a_base(const Unit&) const { return (const char*)A; }
    __device__ __forceinline__ const float* b_base(const Unit& u, int par) const { return (par ? Wu : Wg) + (size_t)u.e * K * ldw + 64 * u.pn; }
    __device__ __forceinline__ unsigned a_voff(const Unit& u, int r, int cb) const { const int last = u.nvalid - 1; r = r < last ? r : last; const int tok = list[(size_t)u.e * T + u.pm * 576 + r]; return (unsigned)(tok * lda + cb); }
    static __device__ __forceinline__ int bsub(int wn, int nb) { return (nb >> 1) * 4 + 2 * wn + (nb & 1); }
};
struct EpiTT8Swiglu {
    unsigned char* O; int ldc;
    __device__ __forceinline__ void operator()(const f32x4 (&acc)[9][4], const Unit& u, int RB, int wm, int wn, int fr, int fq) const {
        unsigned char* base = O + ((size_t)u.pn * MAXSLOT + (size_t)(u.row0 + fr)) * 64 + 32 * wn + 8 * fq;
#pragma unroll
        for (int i = 0; i < 9; ++i) if (4 * i + wm < RB) {
            const f32x4 g0 = acc[i][0] * tt8::SC_INV, g1 = acc[i][1] * tt8::SC_INV, u0 = acc[i][2] * (tt8::SC_INV * tt8::SC_A), u1 = acc[i][3] * (tt8::SC_INV * tt8::SC_A);
#define SMC(g_, u_) __builtin_amdgcn_fmed3f(silu_mul(g_, u_), -440.0f, 440.0f)
            u32x2 w; w.x = tt8::pack4_fp8(SMC(g0[0], u0[0]), SMC(g0[1], u0[1]), SMC(g0[2], u0[2]), SMC(g0[3], u0[3]));
            w.y = tt8::pack4_fp8(SMC(g1[0], u1[0]), SMC(g1[1], u1[1]), SMC(g1[2], u1[2]), SMC(g1[3], u1[3]));
#undef SMC
            *(u32x2*)(base + (size_t)(16 * (4 * i + wm)) * 64) = w; }
    }
};
struct ProbTT8b {
    const unsigned char* A; const float* W; int K, lda, ldw; const volatile LAS int* ul; int nunits; static constexpr size_t a_kstep = (size_t)MAXSLOT * 64;
    __device__ __forceinline__ bool next(int i, Unit& u) const { if (i >= nunits) return false; u.e = __builtin_amdgcn_readfirstlane(ul[8 * i]); u.pn = __builtin_amdgcn_readfirstlane(ul[8 * i + 1]);
        u.pm = __builtin_amdgcn_readfirstlane(ul[8 * i + 2]); u.row0 = __builtin_amdgcn_readfirstlane(ul[8 * i + 3]); u.nvalid = __builtin_amdgcn_readfirstlane(ul[8 * i + 4]); return true; }
    __device__ __forceinline__ const char* a_base(const Unit& u) const { return (const char*)(A + (size_t)u.row0 * 64); }
    __device__ __forceinline__ const float* b_base(const Unit& u, int par) const { return W + (size_t)u.e * K * ldw + 128 * u.pn + 64 * par; }
    __device__ __forceinline__ unsigned a_voff(const Unit& u, int r, int cb) const { const int last = u.nvalid - 1; r = r < last ? r : last; return (unsigned)(r * 64 + cb); }
    static __device__ __forceinline__ int bsub(int wn, int nb) { return 4 * wn + nb; }
};
struct EpiTT8Y {
    bf16_t* O; int ldc;
    __device__ __forceinline__ void operator()(const f32x4 (&acc)[9][4], const Unit& u, int RB, int wm, int wn, int fr, int fq) const {
        bf16_t* base = O + (size_t)(u.row0 + fr) * ldc + 128 * u.pn + 64 * wn + 8 * fq;
#pragma unroll
        for (int i = 0; i < 9; ++i) if (4 * i + wm < RB) {
#pragma unroll
            for (int h = 0; h < 2; ++h) { const f32x4 a0 = acc[i][2 * h] * tt8::SC_INV, a1 = acc[i][2 * h + 1] * tt8::SC_INV;
                u32x4 w; w.x = cvt_pk_bf16(a0[0], a0[1]); w.y = cvt_pk_bf16(a0[2], a0[3]); w.z = cvt_pk_bf16(a1[0], a1[1]); w.w = cvt_pk_bf16(a1[2], a1[3]);
                *(u32x4*)(base + (size_t)(16 * (4 * i + wm)) * ldc + 32 * h) = w; } }
    }
};

__device__ __forceinline__ int build_tt_units(volatile LAS int* misc, unsigned* ctl, int vcu, int G) {
    volatile LAS int* cnt = misc + MISC_ETAB; volatile LAS int* nmt = cnt + 32; volatile LAS int* pst = nmt + 32;
    volatile LAS int* ul = misc + MISC_NUNIT + 8;
    volatile LAS int* che = misc + 512; volatile LAS int* chc = che + 64; volatile LAS int* chr = chc + 64;
    int tid = threadIdx.x; asm volatile("" : "+v"(tid));
    __syncthreads();
    if (tid < 64) {
        const int ln = tid;
        int c = 0; if (ln < 32) c = (int)__hip_atomic_load(ctl + CW_ECNT + 64 * ln, RLX_AGENT);
        const int nm = (c + 255) >> 8, nck = (c + 575) / 576;
        int inm = nm, ick = nck;
#pragma unroll
        for (int o = 1; o < 32; o <<= 1) { const int a = __shfl_up(inm, o), b = __shfl_up(ick, o); if (ln >= o) { inm += a; ick += b; } }
        if (ln < 32) { cnt[ln] = c; nmt[ln] = nm; pst[ln] = 256 * (inm - nm); }
        if (ln == 31) pst[32] = 256 * inm;
        int nch = __builtin_amdgcn_readlane(ick, 31); nch = nch < 64 ? nch : 64;
        const int base = ick - nck;
        for (int rc = 0; rc < nck; ++rc) if (base + rc < 64) { const int nv = c - 576 * rc; che[base + rc] = ln; chc[base + rc] = rc; chr[base + rc] = nv < 576 ? nv : 576; }
        const int L = vcu + G * ln;
        const bool valid = ln < 40 && L < 16 * nch;
        const unsigned long long m = __ballot(valid);
        if (valid) { const int n = __popcll(m & ((1ull << ln) - 1ull)), q = L >> 4, e = che[q], rc = chc[q];
            ul[8 * n] = e; ul[8 * n + 1] = L & 15; ul[8 * n + 2] = rc; ul[8 * n + 3] = pst[e] + 576 * rc; ul[8 * n + 4] = chr[q]; }
        if (ln == 0) misc[MISC_NUNIT] = __popcll(m);
    }
    __syncthreads();
    return misc[MISC_NUNIT];
}

__global__ void __launch_bounds__(NTHREADS, 2) fwd_kernel(Args args) {
    extern __shared__ __attribute__((aligned(16))) unsigned char lds_raw[];
    LAS unsigned char* lds = (LAS unsigned char*)lds_raw;
    volatile LAS int* misc = (volatile LAS int*)(lds + MISC_OFF);
    const int tid = threadIdx.x, lane = tid & 63, wave = __builtin_amdgcn_readfirstlane(tid >> 6);
    const int G = gridDim.x, bx = blockIdx.x;
    const int vcu = (G % 8 == 0) ? (bx % 8) * (G / 8) + bx / 8 : bx;
    const int gw = vcu * NWAVES + wave, NGW = G * NWAVES;

    unsigned char* ws = args.ws;
    unsigned* ctl = (unsigned*)(ws + WS_CTL);
    const float* x = args.in[0]; const float* g1 = args.in[1]; const float* w_in = args.in[2]; const float* w_pool = args.in[3]; const float* pool_scale = args.in[4];
    const float* conv_w = args.in[5]; const float* w_out = args.in[6]; const float* g2 = args.in[7]; const float* w_rg = args.in[8]; const float* b_rg = args.in[9];
    const float* w_re = args.in[10]; const float* b_re = args.in[11]; const float* w_gate = args.in[12]; const float* w_up = args.in[13]; const float* w_down = args.in[14];
    const float* g3 = args.in[15];
    float* out = args.out;
    bf16_t* WRTH = (bf16_t*)(ws + WS_WRT + 512 * 1024); bf16_t* WRTL = (bf16_t*)(ws + WS_WRT + 768 * 1024); bf16_t* WPOOL = (bf16_t*)(ws + WS_WPOOL); int* LIST = (int*)(ws + WS_LIST); i32x4* ASG = (i32x4*)(ws + WS_ASG); f32x2* ASW = (f32x2*)(ws + WS_ASW);
    bf16_t* WIN = (bf16_t*)(ws + WS_WIN); bf16_t* WOUT = (bf16_t*)(ws + WS_WOUT); bf16_t* XN = (bf16_t*)(ws + WS_XN); bf16_t* PROJ = (bf16_t*)(ws + WS_PROJ);
    bf16_t* MIXED = (bf16_t*)(ws + WS_MIXED); bf16_t* MIXO = (bf16_t*)(ws + WS_X1); bf16_t* HID = (bf16_t*)(ws + WS_HID);
    bf16_t* Y = (bf16_t*)(ws + WS_Y);

    for (int u = tid; u < 1024; u += NTHREADS) misc[u] = 0;
    __syncthreads();
    XcdBarrier bar = xcd_barrier_post(ctl + CW_BAR, (volatile LAS unsigned*)(misc + MISC_BAR));

    for (int rep_ = 0; rep_ < REP_P0; ++rep_) {
    {
        {
            int it = vcu;
            f32x4 v[8];
            CvtTile cur = cvt_decode(it < CVT_NTILES ? it : 0, w_in, w_out, WIN, WOUT);
            if (it < CVT_NTILES) {
#pragma unroll
                for (int j = 0; j < 8; ++j) v[j] = __builtin_nontemporal_load((const f32x4*)(cur.src + (size_t)(8 * wave + j) * cur.ldw) + lane);
            }
            int buf = 0;
            while (it < CVT_NTILES) {
                LAS unsigned char* tb = lds + buf * 32768;
                u32x4 p[4];
#pragma unroll
                for (int c = 0; c < 4; ++c) { p[c].x = cvt_pk_bf16(v[0][c], v[1][c]); p[c].y = cvt_pk_bf16(v[2][c], v[3][c]); p[c].z = cvt_pk_bf16(v[4][c], v[5][c]); p[c].w = cvt_pk_bf16(v[6][c], v[7][c]); }
#pragma unroll
                for (int c = 0; c < 4; ++c) { const int r = 4 * lane + c; *(LAS u32x4*)(tb + r * 128 + ((wave ^ swz_f(r)) << 4)) = p[c]; }
                const int nit = it + G; const bool has_next = nit < CVT_NTILES;
                CvtTile nx = cvt_decode(has_next ? nit : 0, w_in, w_out, WIN, WOUT);
                if (has_next) {
#pragma unroll
                    for (int j = 0; j < 8; ++j) v[j] = __builtin_nontemporal_load((const f32x4*)(nx.src + (size_t)(8 * wave + j) * nx.ldw) + lane);
                }
                __syncthreads();
#pragma unroll
                for (int i = 0; i < 4; ++i) { const int r = (tid >> 3) + 64 * i, ch = tid & 7; const u32x4 o = *(const LAS u32x4*)(tb + r * 128 + ((ch ^ swz_f(r)) << 4));
                    *(u32x4*)(cur.dst + (size_t)(cur.n0 + r) * cur.ldt + 8 * ch) = o; }
                buf ^= 1; it = nit; cur = nx;
            }
            __syncthreads();
        }
        for (int i = bx * NTHREADS + tid; i < 4 * 65536; i += G * NTHREADS) { const int g = i >> 16, d = i & 255; WPOOL[i] = (bf16_t)f2bf(w_pool[i] * pool_scale[g * 256 + d]); }
        for (int i = bx * NTHREADS + tid; i < 48 * D; i += G * NTHREADS) { const int c = i / D, k = i % D; const float w = c < 4 ? w_rg[k * 4 + c] * g2[k] : (c < NRC ? w_re[k * 32 + (c - 4)] * g2[k] : 0.f);
            const unsigned hi = f2bf(w); const float wl = w - __builtin_bit_cast(float, hi << 16); WRTH[i] = (bf16_t)hi; WRTL[i] = (bf16_t)f2bf(wl); }
        for (int m = gw; m < T; m += NGW) {
            const f32x4* xr = (const f32x4*)(x + (size_t)m * D) + lane; f32x4 v[8]; float s = 0.f;
#pragma unroll
            for (int j = 0; j < 8; ++j) { v[j] = xr[64 * j]; s += (v[j].x * v[j].x + v[j].y * v[j].y) + (v[j].z * v[j].z + v[j].w * v[j].w); }
            const float rstd = 1.0f / sqrtf(wave_sum(s) * (1.0f / D) + EPS);
            u32x2* o = (u32x2*)(XN + (size_t)m * D) + lane;
#pragma unroll
            for (int j = 0; j < 8; ++j) { const f32x4 g = ((const f32x4*)g1)[64 * j + lane]; u32x2 w; w.x = pk2(v[j].x * rstd * g.x, v[j].y * rstd * g.y); w.y = pk2(v[j].z * rstd * g.z, v[j].w * rstd * g.w); o[64 * j] = w; }
        }
    }
    xcd_barrier(bar);
    }

    for (int rep_ = 0; rep_ < REP_P1; ++rep_) {
    {
        ProbDense P{XN, WIN, D, D, D, T / 256, INC / 256, G, bx};
        EpiBf16 E{PROJ, INC, nullptr, 0};
        pg8::gemm_phase<ProbDense, EpiBf16, true>(lds, P, E);
    }
    xcd_barrier(bar);
    }

    for (int rep_ = 0; rep_ < REP_P2; ++rep_) {
    {
        if (rep_ == 0) { ProbWeff P{WOUT, WPOOL, 256, D, 256, G, vcu}; EpiBf16 E{WOUT, D, nullptr, 1}; pg8::gemm_phase<ProbWeff, EpiBf16, false>(lds, P, E); }
        bf16_t* const POOLDST = MIXED; constexpr int POOLLD = D;
        for (int it = gw; it < 2048; it += NGW) {
            const int part = it >> 10, q = it & 1023, chunk = q >> 1, slab = q & 1, r0 = chunk * 16, c0 = slab * 512 + lane * 8;
#define BF8(v, f) { f[0] = bflo(v.x); f[1] = bfhi(v.x); f[2] = bflo(v.y); f[3] = bfhi(v.y); f[4] = bflo(v.z); f[5] = bfhi(v.z); f[6] = bflo(v.w); f[7] = bfhi(v.w); }
            if (part == 0) {
                const int gi = c0 >> 8, w = 2 << gi;
                float s[8];
#pragma unroll
                for (int j = 0; j < 8; ++j) s[j] = 0.f;
                { u32x4 iv[16];
#pragma unroll
                  for (int i = 0; i < 16; ++i) { const int rr = r0 - 1 - i; iv[i] = *(const u32x4*)(PROJ + (size_t)(rr < 0 ? 0 : rr) * INC + c0); }
#pragma unroll
                  for (int i = 0; i < 16; ++i) { const bool ok = (i < w) && (r0 - 1 - i >= 0); float f[8]; BF8(iv[i], f);
#pragma unroll
                      for (int j = 0; j < 8; ++j) s[j] += ok ? f[j] : 0.f; } }
#pragma unroll 1
                for (int tb = 0; tb < 2; ++tb) {
                    const int t0 = r0 + 8 * tb; u32x4 nv[8], ov[8];
#pragma unroll
                    for (int k = 0; k < 8; ++k) { nv[k] = *(const u32x4*)(PROJ + (size_t)(t0 + k) * INC + c0); const int ro = t0 + k - w; ov[k] = *(const u32x4*)(PROJ + (size_t)(ro < 0 ? 0 : ro) * INC + c0); }
#pragma unroll
                    for (int k = 0; k < 8; ++k) { const int t = t0 + k; float un[8], uo[8]; BF8(nv[k], un); BF8(ov[k], uo); const bool ok = t - w >= 0;
#pragma unroll
                        for (int j = 0; j < 8; ++j) s[j] += un[j] - (ok ? uo[j] : 0.f);
                        const int cn = (t + 1) < w ? (t + 1) : w; const float inv = 1.0f / (float)cn;
                        u32x4 p; p.x = pk2(s[0] * inv - un[0], s[1] * inv - un[1]); p.y = pk2(s[2] * inv - un[2], s[3] * inv - un[3]);
                        p.z = pk2(s[4] * inv - un[4], s[5] * inv - un[5]); p.w = pk2(s[6] * inv - un[6], s[7] * inv - un[7]);
                        *(u32x4*)(POOLDST + (size_t)t * POOLLD + c0) = p; }
                }
            } else {
                float cw[8][3];
#pragma unroll
                for (int j = 0; j < 8; ++j) { cw[j][0] = conv_w[(c0 + j) * 3 + 0]; cw[j][1] = conv_w[(c0 + j) * 3 + 1]; cw[j][2] = conv_w[(c0 + j) * 3 + 2]; }
                float z2[8], z1[8];
                { const int ra = r0 >= 2 ? r0 - 2 : 0, rb = r0 >= 1 ? r0 - 1 : 0;
                  const u32x4 ca = *(const u32x4*)(PROJ + (size_t)ra * INC + MIXA + MIXB + c0), va = *(const u32x4*)(PROJ + (size_t)ra * INC + MIXA + 2 * MIXB + c0);
                  const u32x4 cb = *(const u32x4*)(PROJ + (size_t)rb * INC + MIXA + MIXB + c0), vb = *(const u32x4*)(PROJ + (size_t)rb * INC + MIXA + 2 * MIXB + c0);
                  float fa[8], fb[8], fc[8], fd[8]; BF8(ca, fa); BF8(va, fb); BF8(cb, fc); BF8(vb, fd);
#pragma unroll
                  for (int j = 0; j < 8; ++j) { z2[j] = r0 >= 2 ? fa[j] * fb[j] : 0.f; z1[j] = r0 >= 1 ? fc[j] * fd[j] : 0.f; } }
#pragma unroll 1
                for (int tb = 0; tb < 2; ++tb) {
                    const int t0 = r0 + 8 * tb; u32x4 bbv[8], ccv[8], vvv[8];
#pragma unroll
                    for (int k = 0; k < 8; ++k) { const bf16_t* pr = PROJ + (size_t)(t0 + k) * INC + c0; bbv[k] = *(const u32x4*)(pr + MIXA); ccv[k] = *(const u32x4*)(pr + MIXA + MIXB); vvv[k] = *(const u32x4*)(pr + MIXA + 2 * MIXB); }
#pragma unroll
                    for (int k = 0; k < 8; ++k) { float bg[8], cg[8], vg[8]; BF8(bbv[k], bg); BF8(ccv[k], cg); BF8(vvv[k], vg); float yv[8];
#pragma unroll
                        for (int j = 0; j < 8; ++j) { const float z0 = cg[j] * vg[j]; yv[j] = bg[j] * (z2[j] * cw[j][0] + z1[j] * cw[j][1] + z0 * cw[j][2]); z2[j] = z1[j]; z1[j] = z0; }
                        u32x4 p; p.x = pk2(yv[0], yv[1]); p.y = pk2(yv[2], yv[3]); p.z = pk2(yv[4], yv[5]); p.w = pk2(yv[6], yv[7]);
                        *(u32x4*)(MIXED + (size_t)(t0 + k) * D + MIXA + c0) = p; }
                }
            }
#undef BF8
        }
    }
    xcd_barrier(bar);
    }

    for (int rep_ = 0; rep_ < REP_P4; ++rep_) {
    {
        ProbDense P{MIXED, WOUT, D, D, D, T / 256, D / 256, G, bx};
        EpiBf16 E{MIXO, D, nullptr, 0};
        pg8::gemm_phase<ProbDense, EpiBf16, false>(lds, P, E);
    }
    xcd_barrier(bar);
    }

    for (int rep_ = 0; rep_ < REP_P5; ++rep_) {
    {
        bf16_t* H2 = XN;
        for (int rb = vcu; rb < T / 32; rb += G) {
            const int row0 = rb * 32 + wave * 4;
            float rstd[4]; float mylog[4];
            {
                LAS float* red = (LAS float*)lds;
                LAS float* ssp = red + 8 * 6 * 64 * 4;
                LAS float* lgs = ssp + 8 * 2 * 64;
                LAS float* rsd = lgs + 32 * 48;
                const int rowb = rb * 32, fr = lane & 15, fq = lane >> 4;
                f32x4 acc[2][3];
#pragma unroll
                for (int a = 0; a < 2; ++a)
#pragma unroll
                    for (int c = 0; c < 3; ++c) acc[a][c] = (f32x4){0.f, 0.f, 0.f, 0.f};
                float ssl[2] = {0.f, 0.f};
#pragma unroll 2
                for (int ks = 0; ks < 8; ++ks) {
                    const int k0 = 256 * wave + 32 * ks + 8 * fq;
                    bf16x8 bh[3], bl[3];
#pragma unroll
                    for (int c = 0; c < 3; ++c) { bh[c] = *(const bf16x8*)(WRTH + (size_t)(16 * c + fr) * D + k0); bl[c] = *(const bf16x8*)(WRTL + (size_t)(16 * c + fr) * D + k0); }
#pragma unroll
                    for (int a = 0; a < 2; ++a) { const size_t ro = (size_t)(rowb + 16 * a + fr) * D + k0;
                        const f32x4 xa = *(const f32x4*)(x + ro), xb = *(const f32x4*)(x + ro + 4); const u32x4 mo = *(const u32x4*)(MIXO + ro);
                        const float v[8] = {xa.x + bflo(mo.x), xa.y + bfhi(mo.x), xa.z + bflo(mo.y), xa.w + bfhi(mo.y), xb.x + bflo(mo.z), xb.y + bfhi(mo.z), xb.z + bflo(mo.w), xb.w + bfhi(mo.w)};
                        u32x4 hp, lp;
#pragma unroll
                        for (int q = 0; q < 4; ++q) { const unsigned h = cvt_pk_bf16(v[2 * q], v[2 * q + 1]); hp[q] = h; lp[q] = cvt_pk_bf16(v[2 * q] - bflo(h), v[2 * q + 1] - bfhi(h));
                            ssl[a] += v[2 * q] * v[2 * q] + v[2 * q + 1] * v[2 * q + 1]; }
                        const bf16x8 ah = __builtin_bit_cast(bf16x8, hp), al = __builtin_bit_cast(bf16x8, lp);
#pragma unroll
                        for (int c = 0; c < 3; ++c) { acc[a][c] = __builtin_amdgcn_mfma_f32_16x16x32_bf16(ah, bh[c], acc[a][c], 0, 0, 0); acc[a][c] = __builtin_amdgcn_mfma_f32_16x16x32_bf16(ah, bl[c], acc[a][c], 0, 0, 0);
                            acc[a][c] = __builtin_amdgcn_mfma_f32_16x16x32_bf16(al, bh[c], acc[a][c], 0, 0, 0); } }
                }
#pragma unroll
                for (int a = 0; a < 2; ++a) { ssp[(wave * 2 + a) * 64 + lane] = ssl[a];
#pragma unroll
                    for (int c = 0; c < 3; ++c) *(LAS f32x4*)(red + ((wave * 6 + a * 3 + c) * 64 + lane) * 4) = acc[a][c]; }
                __syncthreads();
#pragma unroll
                for (int i = 0; i < 3; ++i) { const int o = tid + 512 * i, r = o / 48, c = o - 48 * r, a = r >> 4, rr = r & 15, cb = c >> 4, cc = c & 15, ln = cc + 16 * (rr >> 2), reg = rr & 3; float s = 0.f;
#pragma unroll
                    for (int w = 0; w < 8; ++w) s += red[((w * 6 + a * 3 + cb) * 64 + ln) * 4 + reg];
                    lgs[o] = s; }
                if (tid < 32) { const int a = tid >> 4, rr = tid & 15; float s = 0.f;
#pragma unroll
                    for (int w = 0; w < 8; ++w)
#pragma unroll
                        for (int q = 0; q < 4; ++q) s += ssp[(w * 2 + a) * 64 + rr + 16 * q];
                    rsd[tid] = 1.0f / sqrtf(s * (1.0f / D) + EPS); }
                __syncthreads();
#pragma unroll
                for (int r = 0; r < 4; ++r) { rstd[r] = rsd[4 * wave + r]; mylog[r] = (lane < 48 ? lgs[(4 * wave + r) * 48 + lane] : 0.f) * rstd[r]; }
            }
#pragma unroll
            for (int j = 0; j < 8; ++j) { const f32x4 g = ((const f32x4*)g2)[64 * j + lane];
#pragma unroll
                for (int r = 0; r < 4; ++r) { const u32x2 mo = *((const u32x2*)(MIXO + (size_t)(row0 + r) * D + 256 * j) + lane); f32x4 xv = *((const f32x4*)(x + (size_t)(row0 + r) * D + 256 * j) + lane);
                    xv.x += bflo(mo.x); xv.y += bfhi(mo.x); xv.z += bflo(mo.y); xv.w += bfhi(mo.y);
                    const float sc = rstd[r] * tt8::SC_A;
                    ((unsigned*)((unsigned char*)H2 + (size_t)(row0 + r) * D))[64 * j + lane] = tt8::pack4_fp8(xv.x * sc * g.x, xv.y * sc * g.y, xv.z * sc * g.z, xv.w * sc * g.w);
                } }
            const float bias = lane < 4 ? b_rg[lane] : (lane < NRC ? b_re[lane - 4] : 0.f);
#pragma unroll
            for (int r = 0; r < 4; ++r) {
                const float lg = mylog[r] + bias;
                float g[4];
#pragma unroll
                for (int i = 0; i < 4; ++i) g[i] = __shfl(lg, i);
                int grp = 0; float gm = g[0];
#pragma unroll
                for (int i = 1; i < 4; ++i) if (g[i] > gm) { gm = g[i]; grp = i; }
                float gs = 0.f;
#pragma unroll
                for (int i = 0; i < 4; ++i) gs += expf(g[i] - gm);
                const float g_w = 1.0f / gs;
                float el[8];
#pragma unroll
                for (int i = 0; i < 8; ++i) el[i] = __shfl(lg, 4 + grp * 8 + i);
                int i0 = 0; float m0 = el[0];
#pragma unroll
                for (int i = 1; i < 8; ++i) if (el[i] > m0) { m0 = el[i]; i0 = i; }
                int i1 = -1; float m1 = -3.0e38f;
#pragma unroll
                for (int i = 0; i < 8; ++i) if (i != i0 && el[i] > m1) { m1 = el[i]; i1 = i; }
                const float p1 = expf(m1 - m0);
                const float w0 = g_w / (1.0f + p1), w1 = g_w * p1 / (1.0f + p1);
                if (lane == 0) { const int a = (wave * 4 + r) * 2; misc[256 + a] = grp * 8 + i0; misc[256 + a + 1] = grp * 8 + i1;
                    misc[384 + a] = __builtin_bit_cast(int, w0); misc[384 + a + 1] = __builtin_bit_cast(int, w1); }
            }
            __syncthreads();
            if (wave == 0) {
                const int a = lane, tok = rb * 32 + (a >> 1), e = misc[256 + a];
                unsigned long long mym = 0ull;
#pragma unroll 1
                for (int ee = 0; ee < NE; ++ee) { const unsigned long long m = __ballot(e == ee); if (e == ee) mym = m; }
                const int rank = __popcll(mym & ((1ull << lane) - 1ull)), cntl = __popcll(mym), leader = __ffsll((long long)mym) - 1;
                int base = 0;
                if (rank == 0) base = (int)__hip_atomic_fetch_add(ctl + CW_ECNT + 64 * e + (rep_ == REP_P5 - 1 ? 0 : 32), (unsigned)cntl, RLX_AGENT);
                base = __shfl(base, leader);
                const int pos = base + rank;
                LIST[(size_t)e * T + pos] = tok;
                ((int*)ASG)[(size_t)tok * 4 + (a & 1) * 2] = e; ((int*)ASG)[(size_t)tok * 4 + (a & 1) * 2 + 1] = pos;
                ((int*)ASW)[(size_t)tok * 2 + (a & 1)] = misc[384 + a];
            }
            __syncthreads();
        }
    }
    xcd_barrier(bar);
    }

    for (int rep_ = 0; rep_ < REP_P67; ++rep_) {
    {
        const int nu = build_tt_units(misc, ctl, vcu, G);
        ProbTT8a P{(const unsigned char*)XN, w_gate, w_up, LIST, D, D, DE, misc + MISC_NUNIT + 8, nu};
        EpiTT8Swiglu E{(unsigned char*)HID, DE};
        for (int r6_ = 0; r6_ < REP_P6; ++r6_) { if (r6_) xcd_barrier(bar); tt8::gemm_phase<ProbTT8a, EpiTT8Swiglu>(lds, P, E); }
    }
    xcd_barrier(bar);

    {
        const int nu = build_tt_units(misc, ctl, vcu, G);
        ProbTT8b P{(const unsigned char*)HID, w_down, DE, DE, D, misc + MISC_NUNIT + 8, nu};
        EpiTT8Y E{Y, D};
        for (int r7_ = 0; r7_ < REP_P7; ++r7_) { if (r7_) xcd_barrier(bar); tt8::gemm_phase<ProbTT8b, EpiTT8Y>(lds, P, E); }
    }
    xcd_barrier(bar);

    }
    for (int rep_ = 0; rep_ < REP_P8; ++rep_) {
    if (rep_) xcd_barrier(bar);
    {
        volatile LAS int* pst = misc + MISC_ETAB + 64;
        for (int m = gw; m < T; m += NGW) {
            const i32x4 as = ASG[m]; const f32x2 aw = ASW[m];
            const int s0 = pst[as.x] + as.y, s1 = pst[as.z] + as.w;
            const f32x4* xr = (const f32x4*)(x + (size_t)m * D) + lane; const u32x2* mo_ = (const u32x2*)(MIXO + (size_t)m * D) + lane; const u32x2* y0 = (const u32x2*)(Y + (size_t)s0 * D) + lane; const u32x2* y1 = (const u32x2*)(Y + (size_t)s1 * D) + lane;
            f32x4 v[8]; float s = 0.f;
#pragma unroll
            for (int j = 0; j < 8; ++j) { f32x4 xx = xr[64 * j]; const u32x2 a = y0[64 * j], b = y1[64 * j], mo = mo_[64 * j];
                xx.x += bflo(mo.x); xx.y += bfhi(mo.x); xx.z += bflo(mo.y); xx.w += bfhi(mo.y);
                v[j].x = xx.x + aw.x * bflo(a.x) + aw.y * bflo(b.x); v[j].y = xx.y + aw.x * bfhi(a.x) + aw.y * bfhi(b.x);
                v[j].z = xx.z + aw.x * bflo(a.y) + aw.y * bflo(b.y); v[j].w = xx.w + aw.x * bfhi(a.y) + aw.y * bfhi(b.y);
                s += (v[j].x * v[j].x + v[j].y * v[j].y) + (v[j].z * v[j].z + v[j].w * v[j].w); }
            const float rstd = 1.0f / sqrtf(wave_sum(s) * (1.0f / D) + EPS);
            f32x4* o = (f32x4*)(out + (size_t)m * D) + lane;
#pragma unroll
            for (int j = 0; j < 8; ++j) { const f32x4 g = ((const f32x4*)g3)[64 * j + lane]; o[64 * j] = (f32x4){v[j].x * rstd * g.x, v[j].y * rstd * g.y, v[j].z * rstd * g.z, v[j].w * rstd * g.w}; }
        }
    }
    }
}

extern "C" void kernel_launch(void* const* d_in, const int* in_sizes, int n_in, void* d_out, int out_size, void* d_ws, size_t ws_size, hipStream_t stream) {
    static int grid = 0;
    if (grid == 0) {
        if (n_in != 16 || in_sizes[0] != T * D || out_size != T * D || ws_size < WS_END) { fprintf(stderr, "kernel_launch: unexpected shapes (n_in %d, in0 %d, out %d, ws %zu); nothing launched\n", n_in, n_in > 0 ? in_sizes[0] : -1, out_size, ws_size); grid = -1; return; }
        int dev = 0, cus = 0, per_cu = 0;
        if (hipGetDevice(&dev) != hipSuccess || hipDeviceGetAttribute(&cus, hipDeviceAttributeMultiprocessorCount, dev) != hipSuccess) { fprintf(stderr, "kernel_launch: device query failed\n"); grid = -1; return; }
        if (hipFuncSetAttribute((const void*)fwd_kernel, hipFuncAttributeMaxDynamicSharedMemorySize, LDS_BYTES) != hipSuccess) { fprintf(stderr, "kernel_launch: hipFuncSetAttribute failed\n"); grid = -1; return; }
        if (hipOccupancyMaxActiveBlocksPerMultiprocessor(&per_cu, (const void*)fwd_kernel, NTHREADS, LDS_BYTES) != hipSuccess || per_cu < 1) { fprintf(stderr, "kernel_launch: occupancy query says %d blocks per CU; nothing launched\n", per_cu); (void)hipGetLastError(); grid = -1; return; }
        grid = cus;
    }
    if (grid < 0) return;
    if (hipMemsetAsync((char*)d_ws + WS_CTL, 0, CTL_BYTES, stream) != hipSuccess) { fprintf(stderr, "kernel_launch: memset failed\n"); return; }
    Args a{};
    for (int i = 0; i < 16; ++i) a.in[i] = (const float*)d_in[i];
    a.out = (float*)d_out; a.ws = (unsigned char*)d_ws;
    void* kargs[] = {&a};
    hipError_t le = hipLaunchCooperativeKernel((const void*)fwd_kernel, dim3(grid), dim3(NTHREADS), kargs, LDS_BYTES, stream);
    if (le != hipSuccess) fprintf(stderr, "kernel_launch: cooperative launch failed: %s (grid %d)\n", hipGetErrorString(le), grid);
}
```

```cpp
#include <hip/hip_runtime.h>
#include <cstdio>
#include <cstdint>

#define LAS __attribute__((address_space(3)))
#define GAS __attribute__((address_space(1)))
typedef unsigned short bf16_t;
typedef short bf16x8 __attribute__((ext_vector_type(8)));
typedef float f32x4 __attribute__((ext_vector_type(4)));
typedef float f32x2 __attribute__((ext_vector_type(2)));
typedef unsigned u32x4 __attribute__((ext_vector_type(4)));
typedef unsigned u32x2 __attribute__((ext_vector_type(2)));
typedef int i32x4 __attribute__((ext_vector_type(4)));

#ifndef REP_P0
#define REP_P0 1
#endif
#ifndef REP_P1
#define REP_P1 1
#endif
#ifndef REP_P2
#define REP_P2 1
#endif
#ifndef REP_P3
#define REP_P3 1
#endif
#ifndef REP_P4
#define REP_P4 1
#endif
#ifndef REP_P5
#define REP_P5 1
#endif
#ifndef REP_P6
#define REP_P6 1
#endif
#ifndef REP_P7
#define REP_P7 1
#endif
#ifndef REP_P67
#define REP_P67 1
#endif
#ifndef REP_P8
#define REP_P8 1
#endif
constexpr int T = 8192, D = 2048, INC = 4096, MIXA = 1024, MIXB = 1024, NE = 32, DE = 1024, NGRP = 4, EPG = 8;
constexpr int POOLCH = 256, NRC = 36;
constexpr float EPS = 1e-6f;
constexpr int MAXSLOT = 24576;
constexpr int NWAVES = 8, NTHREADS = 512;

constexpr size_t MiB = 1u << 20;
constexpr size_t WS_CTL = 0, CTL_BYTES = 64 * 1024;
constexpr size_t WS_WRT = 1 * MiB;
constexpr size_t WS_WPOOL = 2 * MiB;
constexpr size_t WS_LIST = 3 * MiB;
constexpr size_t WS_ASG = 4 * MiB;
constexpr size_t WS_ASW = 5 * MiB;
constexpr size_t WS_WIN = 8 * MiB;
constexpr size_t WS_WOUT = 24 * MiB;
constexpr size_t WS_XN = 32 * MiB;
constexpr size_t WS_PROJ = 64 * MiB;
constexpr size_t WS_MIXED = 144 * MiB;
constexpr size_t WS_X1 = 176 * MiB;
constexpr size_t WS_HID = 240 * MiB;
constexpr size_t WS_Y = 288 * MiB;
constexpr size_t WS_END = 384 * MiB;
constexpr int CW_ECNT = 1024;
constexpr int CW_BAR = 4096;

constexpr int RING_BYTES = 135168;
constexpr int MISC_OFF = RING_BYTES;
constexpr int MISC_BAR = 0;
constexpr int MISC_ETAB = 16;
constexpr int MISC_NUNIT = 160;
constexpr int LDS_BYTES = 163840;

#define LDS_WAIT() asm volatile("s_waitcnt lgkmcnt(0)" ::: "memory")
#define VM_WAIT() asm volatile("s_waitcnt vmcnt(0)" ::: "memory")
#define RLX_AGENT __ATOMIC_RELAXED, __HIP_MEMORY_SCOPE_AGENT

__device__ __forceinline__ unsigned f2bf(float f) { unsigned u = __builtin_bit_cast(unsigned, f); return (u + 0x7fffu + ((u >> 16) & 1u)) >> 16; }
__device__ __forceinline__ unsigned pk2(float lo, float hi) { return f2bf(lo) | (f2bf(hi) << 16); }
__device__ __forceinline__ unsigned cvt_pk_bf16(float lo, float hi) { unsigned r; asm volatile("v_cvt_pk_bf16_f32 %0, %1, %2" : "=v"(r) : "v"(lo), "v"(hi)); return r; }
__device__ __forceinline__ float bflo(unsigned w) { return __builtin_bit_cast(float, w << 16); }
__device__ __forceinline__ float bfhi(unsigned w) { return __builtin_bit_cast(float, w & 0xffff0000u); }
__device__ __forceinline__ float wave_sum(float v) {
#pragma unroll
    for (int o = 1; o < 64; o <<= 1) v += __shfl_xor(v, o);
    return v;
}

__device__ __forceinline__ float wave_sum_dpp(float v) {
    v += __builtin_bit_cast(float, __builtin_amdgcn_update_dpp(0, __builtin_bit_cast(int, v), 0xB1, 0xF, 0xF, false));
    v += __builtin_bit_cast(float, __builtin_amdgcn_update_dpp(0, __builtin_bit_cast(int, v), 0x4E, 0xF, 0xF, false));
    v += __builtin_bit_cast(float, __builtin_amdgcn_update_dpp(0, __builtin_bit_cast(int, v), 0x141, 0xF, 0xF, false));
    v += __builtin_bit_cast(float, __builtin_amdgcn_update_dpp(0, __builtin_bit_cast(int, v), 0x140, 0xF, 0xF, false));
    v += __builtin_bit_cast(float, __builtin_amdgcn_update_dpp(0, __builtin_bit_cast(int, v), 0x142, 0xA, 0xF, false));
    v += __builtin_bit_cast(float, __builtin_amdgcn_update_dpp(0, __builtin_bit_cast(int, v), 0x143, 0xC, 0xF, false));
    return __builtin_bit_cast(float, __builtin_amdgcn_readlane(__builtin_bit_cast(int, v), 63));
}

#define XB_TMO      128
#define XB_XCNT(j)  (256  + 64 * (j))
#define XB_XSUB(j)  (1280 + 64 * (j))
#define XB_XGEN(j)  (2304 + 64 * (j))
#define XB_TOP      3328
#define XB_TOPGEN   3392
#define XCD_BAR_WORDS 3456
#define XB_SPIN_CAP (1u << 18)
__device__ __forceinline__ unsigned xb_ld(unsigned* p)              { return __hip_atomic_load(p, __ATOMIC_RELAXED, __HIP_MEMORY_SCOPE_AGENT); }
__device__ __forceinline__ unsigned xb_add(unsigned* p, unsigned v) { return __hip_atomic_fetch_add(p, v, __ATOMIC_RELAXED, __HIP_MEMORY_SCOPE_AGENT); }
__device__ __forceinline__ unsigned xb_xcc_id() { return (unsigned)__builtin_amdgcn_s_getreg((3 << 11) | 20) & 0xFu; }
#define XB_SPIN(cond, bar) do { unsigned _sp = 0; while (cond) { __builtin_amdgcn_s_sleep(1); \
    if ((++_sp & 255u) == 0u) { if (xb_ld(&(bar)[XB_TMO])) break; if (_sp > XB_SPIN_CAP) { atomicAdd(&(bar)[XB_TMO], 1u); break; } } } } while (0)
struct XcdBarrier { unsigned* bar; unsigned x; volatile LAS unsigned* st; };
__device__ __forceinline__ XcdBarrier xcd_barrier_post(unsigned* bar, volatile LAS unsigned* st) {
    XcdBarrier b; b.bar = bar; b.x = xb_xcc_id(); b.st = st;
    if (threadIdx.x == 0) (void)xb_add(&bar[XB_XCNT(b.x)], 1u);
    return b;
}
__device__ __forceinline__ void xcd_barrier_complete(unsigned* bar, unsigned x, unsigned& nloc, unsigned& nx) {
    const unsigned G = gridDim.x * gridDim.y * gridDim.z;
    unsigned sum, cnt, mine, sp = 0u;
    for (;;) {
        sum = 0u; cnt = 0u; mine = 0u;
#pragma unroll
        for (unsigned j = 0; j < 16; ++j) { const unsigned c = xb_ld(&bar[XB_XCNT(j)]); sum += c; cnt += (c > 0u) ? 1u : 0u; mine = (j == x) ? c : mine; }
        if (sum == G) break;
        __builtin_amdgcn_s_sleep(1);
        if ((++sp & 255u) == 0u) { if (xb_ld(&bar[XB_TMO])) break; if (sp > XB_SPIN_CAP) { atomicAdd(&bar[XB_TMO], 1u); break; } }
    }
    nloc = mine > 0u ? mine : 1u; nx = cnt > 0u ? cnt : 1u;
}
__device__ __forceinline__ void xcd_barrier(const XcdBarrier& b) {
    asm volatile("s_waitcnt vmcnt(0)" ::: "memory");
    __syncthreads();
    if (threadIdx.x == 0) {
        unsigned* bar = b.bar;
        __builtin_amdgcn_s_waitcnt(0);
        unsigned nloc = b.st[0], nx = b.st[1];
        if (nloc == 0u) { xcd_barrier_complete(bar, b.x, nloc, nx); b.st[0] = nloc; b.st[1] = nx; }
        const unsigned old = xb_add(&bar[XB_XSUB(b.x)], 1u);
        const unsigned gen = old / nloc;
        if (old + 1u == (gen + 1u) * nloc) {
            __builtin_amdgcn_fence(__ATOMIC_RELEASE, "agent");
            asm volatile("s_waitcnt vmcnt(0)" ::: "memory");
            (void)xb_add(&bar[XB_TOP], 1u);
        }
        XB_SPIN(xb_ld(&bar[XB_TOP]) < (gen + 1u) * nx, bar);
        __builtin_amdgcn_fence(__ATOMIC_ACQUIRE, "agent");
        asm volatile("s_waitcnt vmcnt(0)" ::: "memory");
    }
    __syncthreads();
}

namespace pg8 {
constexpr int BM = 256, BK = 64, HALF = 128, HTB = HALF * BK * 2, NXCD = 8, WGM = 8;
__host__ __device__ __forceinline__ int lds_byte(int r, int c) { const int st = (r >> 4) * 2 + (c >> 5), rr = r & 15, cc = c & 31, ob = rr * 64 + cc * 2; return st * 1024 + (ob ^ (((ob >> 9) & 1) << 5)); }
__host__ __device__ __forceinline__ void stage_rc(int b, int& R, int& C) { const int st = b / 1024, sb = b % 1024, swz = sb ^ (((sb >> 9) & 1) << 5); R = (st >> 1) * 16 + swz / 64; C = (st & 1) * 32 + (swz % 64) / 2; }
__host__ __device__ __forceinline__ int perm32(int rho) { const int n = rho >> 4, i = rho & 15; return 8 * (i >> 2) + 4 * n + (i & 3); }

struct Unit { int e, pm, pn, row0, nvalid, p0, p1, self; };

__device__ __forceinline__ bool static_order(int nM, int nN, int G, int c, int i, int& pm, int& pn) {
    const int nwg = nM * nN; const long L = (long)i * G + c; if (L >= nwg) return false;
    int wgid = (int)L; { const int q = nwg / NXCD, r = nwg % NXCD, xcd = wgid % NXCD, off = wgid / NXCD; wgid = (xcd < r ? xcd * (q + 1) : r * (q + 1) + (xcd - r) * q) + off; }
    const int nig = WGM * nN, gid = wgid / nig, fm = gid * WGM, gsz = (nM - fm) < WGM ? (nM - fm) : WGM;
    pm = fm + ((wgid % nig) % gsz); pn = (wgid % nig) / gsz; return true;
}

template <class Prob, class Epi, bool ALIGN_EPI>
__device__ __forceinline__ void gemm_phase(LAS unsigned char* lds, const Prob& P, const Epi& E) {
    int tid_ = threadIdx.x; asm volatile("" : "+v"(tid_));
    const int tid = tid_, wid = __builtin_amdgcn_readfirstlane(tid >> 6), lane = tid & 63, wr = wid >> 2, wc = wid & 3, fr = lane & 15, fq = lane >> 4;
    const int K = P.K, nt = K / BK;
    int Rr[2], Cc[2];
    unsigned voffA[2][2], voffB[2], nvoffA[2][2];
#pragma unroll
    for (int i = 0; i < 2; ++i) { stage_rc(tid * 16 + i * 8192, Rr[i], Cc[i]); const int Rb = Epi::PERM ? ((Rr[i] & ~31) + perm32(Rr[i] & 31)) : Rr[i];
        voffB[i] = (unsigned)(Rb * P.ldb + Cc[i]) * 2u;
        voffA[0][i] = (unsigned)(Rr[i] * P.lda + Cc[i]) * 2u; voffA[1][i] = (unsigned)((Rr[i] + HALF) * P.lda + Cc[i]) * 2u; }
    const size_t kstep = (size_t)(BK * 2);
    const size_t hstepB = (size_t)HALF * P.ldb * 2;
    const unsigned ldsw = (unsigned)wid * 1024u;
    const int aoff = lds_byte(wr * 64 + fr, fq * 8), boff = lds_byte(wc * 32 + fr, fq * 8);
#define PG8_SA(b, h) (((b) * 2 + (h)) * HTB)
#define PG8_SB(b, h) ((4 + (b) * 2 + (h)) * HTB)
#define PG8_STAGE(bufoff, gbase, voff) do { _Pragma("unroll") for (int _i = 0; _i < 2; ++_i) \
        __builtin_amdgcn_global_load_lds((const unsigned*)((const char*)(gbase) + (voff)[_i]), (LAS unsigned*)(lds + (bufoff) + ldsw + _i * 8192), 16, 0, 0); } while (0)
#define PG8_LDA(dst, b, h) do { _Pragma("unroll") for (int m = 0; m < 4; ++m) _Pragma("unroll") for (int k = 0; k < 2; ++k) dst[m][k] = *(const LAS bf16x8*)(lds + PG8_SA(b, h) + aoff + m * 2048 + k * 1024); } while (0)
#define PG8_LDB(dst, b, h) do { _Pragma("unroll") for (int n = 0; n < 2; ++n) _Pragma("unroll") for (int k = 0; k < 2; ++k) dst[n][k] = *(const LAS bf16x8*)(lds + PG8_SB(b, h) + boff + n * 2048 + k * 1024); } while (0)
#define PG8_MMA(ai, bj, At, Bt) do { __builtin_amdgcn_s_setprio(1); _Pragma("unroll") for (int m = 0; m < 4; ++m) _Pragma("unroll") for (int n = 0; n < 2; ++n) _Pragma("unroll") for (int k = 0; k < 2; ++k) \
        acc[ai][bj][m][n] = __builtin_amdgcn_mfma_f32_16x16x32_bf16(Bt[n][k], At[m][k], acc[ai][bj][m][n], 0, 0, 0); __builtin_amdgcn_s_setprio(0); } while (0)
#define PG8_WAIT_V(n) asm volatile("s_waitcnt vmcnt(" #n ")" ::: "memory")
#define PG8_WAIT_L(n) asm volatile("s_waitcnt lgkmcnt(" #n ")" ::: "memory")
#define PG8_BAR __builtin_amdgcn_s_barrier()
#define PG8_SCHED __builtin_amdgcn_sched_barrier(0)
    Unit cur, nxt; int ui = 0;
    if (!P.next(0, cur)) return;
    f32x4 acc[2][2][4][2];
#pragma unroll
    for (int a = 0; a < 2; ++a)
#pragma unroll
        for (int b = 0; b < 2; ++b)
#pragma unroll
            for (int m = 0; m < 4; ++m)
#pragma unroll
                for (int n = 0; n < 2; ++n) acc[a][b][m][n] = (f32x4){0.f, 0.f, 0.f, 0.f};
    bf16x8 At[4][2], B0[2][2], B1[2][2];
    const char* cA = P.a_base(cur); const char* cB = P.b_base(cur);
    if constexpr (Prob::GATHER) P.a_voff(cur, Rr, Cc, voffA);
    PG8_STAGE(PG8_SB(0, 0), cB, voffB); PG8_STAGE(PG8_SB(0, 1), cB + hstepB, voffB); PG8_STAGE(PG8_SA(0, 0), cA, voffA[0]); PG8_STAGE(PG8_SA(0, 1), cA, voffA[1]);
    if (wr == 1) PG8_BAR;
    PG8_WAIT_V(2); PG8_BAR;
    PG8_STAGE(PG8_SB(1, 0), cB + kstep, voffB); PG8_STAGE(PG8_SA(1, 0), cA + kstep, voffA[0]); PG8_STAGE(PG8_SB(1, 1), cB + hstepB + kstep, voffB);
    PG8_WAIT_V(6); PG8_BAR;
    for (;;) {
        const bool has_next = P.next(ui + 1, nxt);
        const char* nA = has_next ? P.a_base(nxt) : cA; const char* nB = has_next ? P.b_base(nxt) : cB;
        if constexpr (Prob::GATHER) {
            if (has_next) P.a_voff(nxt, Rr, Cc, nvoffA);
            else { nvoffA[0][0] = voffA[0][0]; nvoffA[0][1] = voffA[0][1]; nvoffA[1][0] = voffA[1][0]; nvoffA[1][1] = voffA[1][1]; }
        }
        for (int t = 0; t < nt; t += 2) {
            const bool last = (t == nt - 2);
            const char* a1 = cA + (size_t)(t + 1) * kstep;
            const char* a2 = last ? nA : cA + (size_t)(t + 2) * kstep; const char* b2 = last ? nB : cB + (size_t)(t + 2) * kstep;
            const char* a3 = a2 + kstep; const char* b3 = b2 + kstep;
            PG8_LDB(B0, 0, 0); PG8_LDB(B1, 0, 1); PG8_SCHED; PG8_LDA(At, 0, 0); PG8_STAGE(PG8_SA(1, 1), a1, voffA[1]);
            if constexpr (Prob::GATHER) { if (last) { voffA[0][0] = nvoffA[0][0]; voffA[0][1] = nvoffA[0][1]; voffA[1][0] = nvoffA[1][0]; voffA[1][1] = nvoffA[1][1]; } }
            PG8_WAIT_V(8); PG8_WAIT_L(0); PG8_BAR; PG8_MMA(0, 0, At, B0); PG8_MMA(0, 1, At, B1); PG8_BAR; PG8_SCHED;
            PG8_LDA(At, 0, 1); PG8_STAGE(PG8_SB(0, 0), b2, voffB); PG8_STAGE(PG8_SB(0, 1), b2 + hstepB, voffB); PG8_STAGE(PG8_SA(0, 0), a2, voffA[0]);
            PG8_WAIT_V(8); PG8_WAIT_L(0); PG8_BAR; PG8_MMA(1, 0, At, B0); PG8_MMA(1, 1, At, B1); PG8_BAR; PG8_SCHED;
            PG8_LDB(B0, 1, 0); PG8_LDB(B1, 1, 1); PG8_SCHED; PG8_LDA(At, 1, 0); PG8_STAGE(PG8_SA(0, 1), a2, voffA[1]);
            PG8_WAIT_V(8); PG8_WAIT_L(0); PG8_BAR; PG8_MMA(0, 0, At, B0); PG8_MMA(0, 1, At, B1); PG8_BAR; PG8_SCHED;
            PG8_LDA(At, 1, 1); PG8_STAGE(PG8_SB(1, 0), b3, voffB); PG8_STAGE(PG8_SB(1, 1), b3 + hstepB, voffB); PG8_STAGE(PG8_SA(1, 0), a3, voffA[0]);
            PG8_WAIT_V(8); PG8_WAIT_L(0); PG8_BAR; PG8_MMA(1, 0, At, B0); PG8_MMA(1, 1, At, B1); PG8_BAR; PG8_SCHED;
        }
        if constexpr (ALIGN_EPI) { if (wr == 0) PG8_BAR; }
        if constexpr (Epi::DRAIN_FIRST) __builtin_amdgcn_s_waitcnt(0x0F70);
        E(acc, cur, wr, wc, fr, fq);
        if (!has_next) break;
#pragma unroll
        for (int a = 0; a < 2; ++a)
#pragma unroll
            for (int b = 0; b < 2; ++b)
#pragma unroll
                for (int m = 0; m < 4; ++m)
#pragma unroll
                    for (int n = 0; n < 2; ++n) acc[a][b][m][n] = (f32x4){0.f, 0.f, 0.f, 0.f};
        cur = nxt; cA = nA; cB = nB; ++ui;
        if constexpr (ALIGN_EPI) { if (wr == 1) PG8_BAR; }
    }
    PG8_WAIT_V(0);
    if constexpr (!ALIGN_EPI) { if (wr == 0) PG8_BAR; }
    PG8_BAR;
#undef PG8_SA
#undef PG8_SB
#undef PG8_STAGE
#undef PG8_LDA
#undef PG8_LDB
#undef PG8_MMA
#undef PG8_WAIT_V
#undef PG8_WAIT_L
#undef PG8_BAR
#undef PG8_SCHED
}
}
using pg8::Unit;

struct ProbDense {
    static constexpr bool GATHER = false;
    const bf16_t* A; const bf16_t* Bt; int K, lda, ldb, nM, nN, G, c;
    __device__ __forceinline__ bool next(int i, Unit& u) const { u.e = 0; u.row0 = 0; u.nvalid = 256; return pg8::static_order(nM, nN, G, c, i, u.pm, u.pn); }
    __device__ __forceinline__ const char* a_base(const Unit& u) const { return (const char*)(A + (size_t)u.pm * 256 * lda); }
    __device__ __forceinline__ const char* b_base(const Unit& u) const { return (const char*)(Bt + (size_t)u.pn * 256 * ldb); }
    __device__ __forceinline__ void a_voff(const Unit&, const int*, const int*, unsigned (&)[2][2]) const {}
};
struct ProbWeff {
    static constexpr bool GATHER = false;
    const bf16_t* A; const bf16_t* Bt; int K, lda, ldb, G, c;
    __device__ __forceinline__ bool next(int i, Unit& u) const { const int L = i * G + c; if (L >= 32) return false; u.pm = L & 7; u.e = L >> 3; u.pn = 0; u.row0 = 0; u.nvalid = 256; return true; }
    __device__ __forceinline__ const char* a_base(const Unit& u) const { return (const char*)(A + (size_t)u.pm * 256 * lda + u.e * 256); }
    __device__ __forceinline__ const char* b_base(const Unit& u) const { return (const char*)(Bt + (size_t)u.e * 256 * 256); }
    __device__ __forceinline__ void a_voff(const Unit&, const int*, const int*, unsigned (&)[2][2]) const {}
};
struct EpiBf16 {
    static constexpr bool PERM = true, DRAIN_FIRST = false;
    bf16_t* O; int ldc; const float* scale; int mode;
    __device__ __forceinline__ void operator()(const f32x4 (&acc)[2][2][4][2], const Unit& u, int wr, int wc, int fr, int fq) const {
        const int rb = (mode == 2 ? u.row0 : u.pm * 256) + wr * 64 + fr; const int cb = (mode == 1 ? u.e * 256 : u.pn * 256) + wc * 32 + 8 * fq;
        f32x4 sv[2][2];
#pragma unroll
        for (int bj = 0; bj < 2; ++bj)
#pragma unroll
            for (int n = 0; n < 2; ++n) sv[bj][n] = scale ? *(const f32x4*)(scale + cb + bj * 128 + 4 * n) : (f32x4){1.f, 1.f, 1.f, 1.f};
#pragma unroll
        for (int ai = 0; ai < 2; ++ai)
#pragma unroll
            for (int m = 0; m < 4; ++m) { bf16_t* rowp = O + (size_t)(rb + ai * 128 + m * 16) * ldc + cb;
#pragma unroll
                for (int bj = 0; bj < 2; ++bj) { const f32x4 v0 = acc[ai][bj][m][0] * sv[bj][0], v1 = acc[ai][bj][m][1] * sv[bj][1];
                    u32x4 w; w.x = cvt_pk_bf16(v0[0], v0[1]); w.y = cvt_pk_bf16(v0[2], v0[3]); w.z = cvt_pk_bf16(v1[0], v1[1]); w.w = cvt_pk_bf16(v1[2], v1[3]);
                    *(u32x4*)(rowp + bj * 128) = w; } }
    }
};
struct EpiResF32 {
    static constexpr bool PERM = false, DRAIN_FIRST = true;
    const float* base; float* out; int ldc;
    __device__ __forceinline__ void operator()(const f32x4 (&acc)[2][2][4][2], const Unit& u, int wr, int wc, int fr, int fq) const {
        const int rb = u.pm * 256 + wr * 64 + fr, cb = u.pn * 256 + wc * 32 + 4 * fq;
#pragma unroll
        for (int ai = 0; ai < 2; ++ai) {
            f32x4 bs[4][2][2];
#pragma unroll
            for (int m = 0; m < 4; ++m) { const size_t off = (size_t)(rb + ai * 128 + m * 16) * ldc + cb;
#pragma unroll
                for (int bj = 0; bj < 2; ++bj)
#pragma unroll
                    for (int n = 0; n < 2; ++n) bs[m][bj][n] = *(const f32x4*)(base + off + bj * 128 + n * 16); }
            asm volatile("" ::: "memory");
#pragma unroll
            for (int m = 0; m < 4; ++m) { const size_t off = (size_t)(rb + ai * 128 + m * 16) * ldc + cb;
#pragma unroll
                for (int bj = 0; bj < 2; ++bj)
#pragma unroll
                    for (int n = 0; n < 2; ++n) *(f32x4*)(out + off + bj * 128 + n * 16) = bs[m][bj][n] + acc[ai][bj][m][n]; }
            asm volatile("" ::: "memory");
        }
    }
};
__device__ __forceinline__ float silu_mul(float g, float u) { const float e = __builtin_amdgcn_exp2f(g * -1.44269504089f); return g * __builtin_amdgcn_rcpf(1.0f + e) * u; }
namespace tt { constexpr int MAXRB = 36, STAGE = (MAXRB + 8) * 1024, NST = 3; }
struct Args { const float* in[16]; float* out; unsigned char* ws; };

__device__ __forceinline__ int swz_f(int r) { return ((r >> 1) & 7) ^ (((r >> 2) ^ (r >> 3)) & 1) ^ ((r >> 4) & 1); }
struct CvtTile { const float* src; bf16_t* dst; int ldw, ldt, n0; };
__device__ __forceinline__ CvtTile cvt_decode(int it, const float* w_in, const float* w_out, bf16_t* WIN, bf16_t* WOUT) {
    CvtTile t;
    constexpr int I_IN = 32 * 16;
    if (it < I_IN) { const int kb = it / 16, nb = it % 16; t.src = w_in + (size_t)(64 * kb) * INC + 256 * nb; t.dst = WIN + 64 * kb; t.ldw = INC; t.ldt = D; t.n0 = 256 * nb; return t; }
    const int r = it - I_IN, kb = r / 8, nb = r % 8; t.src = w_out + (size_t)(64 * kb) * D + 256 * nb; t.dst = WOUT + 64 * kb; t.ldw = D; t.ldt = D; t.n0 = 256 * nb;
    return t;
}
constexpr int CVT_NTILES = 32 * 16 + 32 * 8;

namespace tt8 {
using pg8::Unit;
constexpr int MAXRB = tt::MAXRB, STAGE = tt::STAGE, NST = tt::NST;
constexpr float SC_A = 8.0f, SC_B = 32.0f, SC_INV = 1.0f / (SC_A * SC_B);
__device__ __forceinline__ unsigned pack4_fp8(float a, float b, float c, float d) { int v = __builtin_amdgcn_cvt_pk_fp8_f32(a, b, 0, false); v = __builtin_amdgcn_cvt_pk_fp8_f32(c, d, v, true); return (unsigned)v; }
template <class Prob, class Epi>
__device__ __forceinline__ void gemm_phase(LAS unsigned char* lds, const Prob& P, const Epi& E) {
    int tid_ = threadIdx.x; asm volatile("" : "+v"(tid_));
    const int tid = tid_, wid = __builtin_amdgcn_readfirstlane(tid >> 6), lane = tid & 63, fr = lane & 15, fq = lane >> 4, wm = wid >> 1, wn = wid & 1;
    const int nt = P.K / 64;
    const int Rl = lane >> 2, Cb = 16 * ((lane & 3) ^ ((Rl >> 2) & 3));
    const int swr = ((fr >> 2) & 3) << 1, roff0 = fr * 64 + ((fq ^ swr) << 3), roff1 = fr * 64 + (((4 + fq) ^ swr) << 3);
    const int cq = lane & 31, kq = 2 * wid + (lane >> 5);
    int bw; { const int tc0 = 4 * cq, c32 = tc0 & 31, a_ = c32 >> 3, b_ = (c32 >> 2) & 1, rho0 = (tc0 & ~31) + 16 * b_ + 4 * a_;
        bw = (MAXRB + (rho0 >> 4)) * 1024 + (rho0 & 15) * 64 + ((((kq >> 1) ^ (a_ << 1)) & 7) << 3) + 4 * (kq & 1); }
    Unit u;
    for (int ui = 0; P.next(ui, u); ++ui) {
        const int RB = (u.nvalid + 15) >> 4, nblk = (RB - wm + 3) >> 2;
        const char* cA = P.a_base(u);
        const float* lB = P.b_base(u, cq >> 4) + 4 * (cq & 15) + (size_t)(4 * kq) * P.ldw;
        unsigned voffA[5]; int pidx[5];
#pragma unroll
        for (int i = 0; i < 5; ++i) { int p = wid + 8 * i; p = p < RB ? p : RB - 1; pidx[i] = p; voffA[i] = P.a_voff(u, 16 * p + Rl, Cb); }
        f32x4 acc[9][4];
#pragma unroll
        for (int i = 0; i < 9; ++i)
#pragma unroll
            for (int n = 0; n < 4; ++n) acc[i][n] = (f32x4){0.f, 0.f, 0.f, 0.f};
        f32x4 b0[4];
#define TT8_STAGE_A(st, kt) do { LAS unsigned char* sb_ = lds + (st) * STAGE; _Pragma("unroll") for (int i_ = 0; i_ < 5; ++i_) \
            __builtin_amdgcn_global_load_lds((const unsigned*)(cA + (size_t)(kt) * P.a_kstep + voffA[i_]), (LAS unsigned*)(sb_ + pidx[i_] * 1024), 16, 0, 0); } while (0)
#define TT8_LOAD_B(set, kt) do { const float* r_ = lB + (size_t)(kt) * 64 * P.ldw; _Pragma("unroll") for (int j_ = 0; j_ < 4; ++j_) { const float* p_ = r_ + (size_t)j_ * P.ldw; \
            asm volatile("global_load_dwordx4 %0, %1, off" : "=v"(set[j_]) : "v"(p_) : "memory"); } } while (0)
#define TT8_WRITE_B(set, st) do { _Pragma("unroll") for (int c_ = 0; c_ < 4; ++c_) \
            *(LAS unsigned*)(lds + (st) * STAGE + bw + 64 * c_) = pack4_fp8(set[0][c_] * SC_B, set[1][c_] * SC_B, set[2][c_] * SC_B, set[3][c_] * SC_B); } while (0)
#define TT8_WAIT(n, set) asm volatile("s_waitcnt vmcnt(" #n ")" : "+v"(set[0]), "+v"(set[1]), "+v"(set[2]), "+v"(set[3]) :: "memory")
        asm volatile("s_waitcnt vmcnt(0) lgkmcnt(0)" ::: "memory"); __builtin_amdgcn_s_barrier();
        TT8_LOAD_B(b0, 0); TT8_STAGE_A(0, 0);
        TT8_WAIT(5, b0); TT8_WRITE_B(b0, 0);
        TT8_LOAD_B(b0, 1); TT8_STAGE_A(1, 1);
        int st = 0;
#define TT8_AF(dst, g_) do { _Pragma("unroll") for (int i = 0; i < 3; ++i) { dst[i][0] = *(const LAS long*)(sa_ + (4 * (3 * (g_) + i) + wm) * 1024 + roff0); dst[i][1] = *(const LAS long*)(sa_ + (4 * (3 * (g_) + i) + wm) * 1024 + roff1); } } while (0)
#define TT8_MM(src, g_) do { __builtin_amdgcn_s_setprio(1); \
            _Pragma("unroll") for (int i = 0; i < 3; ++i) { if (3 * (g_) + i < nblk) { _Pragma("unroll") for (int ks = 0; ks < 2; ++ks) _Pragma("unroll") for (int nb = 0; nb < 4; ++nb) \
                acc[3 * (g_) + i][nb] = __builtin_amdgcn_mfma_f32_16x16x32_fp8_fp8(bf_[nb][ks], src[i][ks], acc[3 * (g_) + i][nb], 0, 0, 0); } } \
            __builtin_amdgcn_s_setprio(0); } while (0)
#define TT8_STEP(t, SET) do { \
            TT8_WAIT(5, SET); asm volatile("s_waitcnt lgkmcnt(0)" ::: "memory"); __builtin_amdgcn_s_barrier();     \
            int s1_ = st + 1; s1_ = s1_ >= NST ? s1_ - NST : s1_; int s2_ = s1_ + 1; s2_ = s2_ >= NST ? s2_ - NST : s2_; \
            TT8_WRITE_B(SET, s1_); \
            { const int t3_ = (t) + 2 < nt ? (t) + 2 : nt - 1; TT8_LOAD_B(SET, t3_); } \
            { const int t2_ = (t) + 2 < nt ? (t) + 2 : nt - 1; TT8_STAGE_A(s2_, t2_); } \
            const LAS unsigned char* sa_ = lds + st * STAGE; \
            long bf_[4][2]; _Pragma("unroll") for (int nb = 0; nb < 4; ++nb) { bf_[nb][0] = *(const LAS long*)(sa_ + (MAXRB + Prob::bsub(wn, nb)) * 1024 + roff0); bf_[nb][1] = *(const LAS long*)(sa_ + (MAXRB + Prob::bsub(wn, nb)) * 1024 + roff1); } \
            long afa_[3][2], afb_[3][2]; \
            TT8_AF(afa_, 0); TT8_AF(afb_, 1);        \
            TT8_MM(afa_, 0); \
            TT8_AF(afa_, 2); \
            TT8_MM(afb_, 1); \
            TT8_MM(afa_, 2); \
            st = s1_; } while (0)
        for (int t = 0; t < nt; ++t) { TT8_STEP(t, b0); }
        TT8_WAIT(0, b0);
        E(acc, u, RB, wm, wn, fr, fq);
#undef TT8_STAGE_A
#undef TT8_LOAD_B
#undef TT8_WRITE_B
#undef TT8_WAIT
#undef TT8_STEP
#undef TT8_AF
#undef TT8_MM
    }
    asm volatile("s_waitcnt vmcnt(0) lgkmcnt(0)" ::: "memory"); __builtin_amdgcn_s_barrier();
}
}
struct ProbTT8a {
    const unsigned char* A; const float* Wg; const float* Wu; const int* list; int K, lda, ldw; const volatile LAS int* ul; int nunits; static constexpr size_t a_kstep = 64;
    __device__ __forceinline__ bool next(int i, Unit& u) const { if (i >= nunits) return false; u.e = __builtin_amdgcn_readfirstlane(ul[8 * i]); u.pn = __builtin_amdgcn_readfirstlane(ul[8 * i + 1]);
        u.pm = __builtin_amdgcn_readfirstlane(ul[8 * i + 2]); u.row0 = __builtin_amdgcn_readfirstlane(ul[8 * i + 3]); u.nvalid = __builtin_amdgcn_readfirstlane(ul[8 * i + 4]); return true; }
    __device__ __forceinline__ const char* a_base(const Unit&) const { return (const char*)A; }
    __device__ __forceinline__ const float* b_base(const Unit& u, int par) const { return (par ? Wu : Wg) + (size_t)u.e * K * ldw + 64 * u.pn; }
    __device__ __forceinline__ unsigned a_voff(const Unit& u, int r, int cb) const { const int last = u.nvalid - 1; r = r < last ? r : last; const int tok = list[(size_t)u.e * T + u.pm * 576 + r]; return (unsigned)(tok * lda + cb); }
    static __device__ __forceinline__ int bsub(int wn, int nb) { return (nb >> 1) * 4 + 2 * wn + (nb & 1); }
};
struct EpiTT8Swiglu {
    unsigned char* O; int ldc;
    __device__ __forceinline__ void operator()(const f32x4 (&acc)[9][4], const Unit& u, int RB, int wm, int wn, int fr, int fq) const {
        unsigned char* base = O + ((size_t)u.pn * MAXSLOT + (size_t)(u.row0 + fr)) * 64 + 32 * wn + 8 * fq;
#pragma unroll
        for (int i = 0; i < 9; ++i) if (4 * i + wm < RB) {
            const f32x4 g0 = acc[i][0] * tt8::SC_INV, g1 = acc[i][1] * tt8::SC_INV, u0 = acc[i][2] * (tt8::SC_INV * tt8::SC_A), u1 = acc[i][3] * (tt8::SC_INV * tt8::SC_A);
#define SMC(g_, u_) __builtin_amdgcn_fmed3f(silu_mul(g_, u_), -440.0f, 440.0f)
            u32x2 w; w.x = tt8::pack4_fp8(SMC(g0[0], u0[0]), SMC(g0[1], u0[1]), SMC(g0[2], u0[2]), SMC(g0[3], u0[3]));
            w.y = tt8::pack4_fp8(SMC(g1[0], u1[0]), SMC(g1[1], u1[1]), SMC(g1[2], u1[2]), SMC(g1[3], u1[3]));
#undef SMC
            *(u32x2*)(base + (size_t)(16 * (4 * i + wm)) * 64) = w; }
    }
};
struct ProbTT8b {
    const unsigned char* A; const float* W; int K, lda, ldw; const volatile LAS int* ul; int nunits; static constexpr size_t a_kstep = (size_t)MAXSLOT * 64;
    __device__ __forceinline__ bool next(int i, Unit& u) const { if (i >= nunits) return false; u.e = __builtin_amdgcn_readfirstlane(ul[8 * i]); u.pn = __builtin_amdgcn_readfirstlane(ul[8 * i + 1]);
        u.pm = __builtin_amdgcn_readfirstlane(ul[8 * i + 2]); u.row0 = __builtin_amdgcn_readfirstlane(ul[8 * i + 3]); u.nvalid = __builtin_amdgcn_readfirstlane(ul[8 * i + 4]); return true; }
    __device__ __forceinline__ const char* a_base(const Unit& u) const { return (const char*)(A + (size_t)u.row0 * 64); }
    __device__ __forceinline__ const float* b_base(const Unit& u, int par) const { return W + (size_t)u.e * K * ldw + 128 * u.pn + 64 * par; }
    __device__ __forceinline__ unsigned a_voff(const Unit& u, int r, int cb) const { const int last = u.nvalid - 1; r = r < last ? r : last; return (unsigned)(r * 64 + cb); }
    static __device__ __forceinline__ int bsub(int wn, int nb) { return 4 * wn + nb; }
};
struct EpiTT8Y {
    bf16_t* O; int ldc;
    __device__ __forceinline__ void operator()(const f32x4 (&acc)[9][4], const Unit& u, int RB, int wm, int wn, int fr, int fq) const {
        bf16_t* base = O + (size_t)(u.row0 + fr) * ldc + 128 * u.pn + 64 * wn + 8 * fq;
#pragma unroll
        for (int i = 0; i < 9; ++i) if (4 * i + wm < RB) {
#pragma unroll
            for (int h = 0; h < 2; ++h) { const f32x4 a0 = acc[i][2 * h] * tt8::SC_INV, a1 = acc[i][2 * h + 1] * tt8::SC_INV;
                u32x4 w; w.x = cvt_pk_bf16(a0[0], a0[1]); w.y = cvt_pk_bf16(a0[2], a0[3]); w.z = cvt_pk_bf16(a1[0], a1[1]); w.w = cvt_pk_bf16(a1[2], a1[3]);
                *(u32x4*)(base + (size_t)(16 * (4 * i + wm)) * ldc + 32 * h) = w; } }
    }
};

__device__ __forceinline__ int build_tt_units(volatile LAS int* misc, unsigned* ctl, int vcu, int G) {
    volatile LAS int* cnt = misc + MISC_ETAB; volatile LAS int* nmt = cnt + 32; volatile LAS int* pst = nmt + 32;
    volatile LAS int* ul = misc + MISC_NUNIT + 8;
    volatile LAS int* che = misc + 512; volatile LAS int* chc = che + 64; volatile LAS int* chr = chc + 64;
    int tid = threadIdx.x; asm volatile("" : "+v"(tid));
    __syncthreads();
    if (tid < 64) {
        const int ln = tid;
        int c = 0; if (ln < 32) c = (int)__hip_atomic_load(ctl + CW_ECNT + 64 * ln, RLX_AGENT);
        const int nm = (c + 255) >> 8, nck = (c + 575) / 576;
        int inm = nm, ick = nck;
#pragma unroll
        for (int o = 1; o < 32; o <<= 1) { const int a = __shfl_up(inm, o), b = __shfl_up(ick, o); if (ln >= o) { inm += a; ick += b; } }
        if (ln < 32) { cnt[ln] = c; nmt[ln] = nm; pst[ln] = 256 * (inm - nm); }
        if (ln == 31) pst[32] = 256 * inm;
        int nch = __builtin_amdgcn_readlane(ick, 31); nch = nch < 64 ? nch : 64;
        const int base = ick - nck;
        for (int rc = 0; rc < nck; ++rc) if (base + rc < 64) { const int nv = c - 576 * rc; che[base + rc] = ln; chc[base + rc] = rc; chr[base + rc] = nv < 576 ? nv : 576; }
        const int L = vcu + G * ln;
        const bool valid = ln < 40 && L < 16 * nch;
        const unsigned long long m = __ballot(valid);
        if (valid) { const int n = __popcll(m & ((1ull << ln) - 1ull)), q = L >> 4, e = che[q], rc = chc[q];
            ul[8 * n] = e; ul[8 * n + 1] = L & 15; ul[8 * n + 2] = rc; ul[8 * n + 3] = pst[e] + 576 * rc; ul[8 * n + 4] = chr[q]; }
        if (ln == 0) misc[MISC_NUNIT] = __popcll(m);
    }
    __syncthreads();
    return misc[MISC_NUNIT];
}

__global__ void __launch_bounds__(NTHREADS, 2) fwd_kernel(Args args) {
    extern __shared__ __attribute__((aligned(16))) unsigned char lds_raw[];
    LAS unsigned char* lds = (LAS unsigned char*)lds_raw;
    volatile LAS int* misc = (volatile LAS int*)(lds + MISC_OFF);
    const int tid = threadIdx.x, lane = tid & 63, wave = __builtin_amdgcn_readfirstlane(tid >> 6);
    const int G = gridDim.x, bx = blockIdx.x;
    const int vcu = (G % 8 == 0) ? (bx % 8) * (G / 8) + bx / 8 : bx;
    const int gw = vcu * NWAVES + wave, NGW = G * NWAVES;

    unsigned char* ws = args.ws;
    unsigned* ctl = (unsigned*)(ws + WS_CTL);
    const float* x = args.in[0]; const float* g1 = args.in[1]; const float* w_in = args.in[2]; const float* w_pool = args.in[3]; const float* pool_scale = args.in[4];
    const float* conv_w = args.in[5]; const float* w_out = args.in[6]; const float* g2 = args.in[7]; const float* w_rg = args.in[8]; const float* b_rg = args.in[9];
    const float* w_re = args.in[10]; const float* b_re = args.in[11]; const float* w_gate = args.in[12]; const float* w_up = args.in[13]; const float* w_down = args.in[14];
    const float* g3 = args.in[15];
    float* out = args.out;
    bf16_t* WRTH = (bf16_t*)(ws + WS_WRT + 512 * 1024); bf16_t* WRTL = (bf16_t*)(ws + WS_WRT + 768 * 1024); bf16_t* WPOOL = (bf16_t*)(ws + WS_WPOOL); int* LIST = (int*)(ws + WS_LIST); i32x4* ASG = (i32x4*)(ws + WS_ASG); f32x2* ASW = (f32x2*)(ws + WS_ASW);
    bf16_t* WIN = (bf16_t*)(ws + WS_WIN); bf16_t* WOUT = (bf16_t*)(ws + WS_WOUT); bf16_t* XN = (bf16_t*)(ws + WS_XN); bf16_t* PROJ = (bf16_t*)(ws + WS_PROJ);
    bf16_t* MIXED = (bf16_t*)(ws + WS_MIXED); bf16_t* MIXO = (bf16_t*)(ws + WS_X1); bf16_t* HID = (bf16_t*)(ws + WS_HID);
    bf16_t* Y = (bf16_t*)(ws + WS_Y);

    for (int u = tid; u < 1024; u += NTHREADS) misc[u] = 0;
    __syncthreads();
    XcdBarrier bar = xcd_barrier_post(ctl + CW_BAR, (volatile LAS unsigned*)(misc + MISC_BAR));

    for (int rep_ = 0; rep_ < REP_P0; ++rep_) {
    {
        {
            int it = vcu;
            f32x4 v[8];
            CvtTile cur = cvt_decode(it < CVT_NTILES ? it : 0, w_in, w_out, WIN, WOUT);
            if (it < CVT_NTILES) {
#pragma unroll
                for (int j = 0; j < 8; ++j) v[j] = __builtin_nontemporal_load((const f32x4*)(cur.src + (size_t)(8 * wave + j) * cur.ldw) + lane);
            }
            int buf = 0;
            while (it < CVT_NTILES) {
                LAS unsigned char* tb = lds + buf * 32768;
                u32x4 p[4];
#pragma unroll
                for (int c = 0; c < 4; ++c) { p[c].x = cvt_pk_bf16(v[0][c], v[1][c]); p[c].y = cvt_pk_bf16(v[2][c], v[3][c]); p[c].z = cvt_pk_bf16(v[4][c], v[5][c]); p[c].w = cvt_pk_bf16(v[6][c], v[7][c]); }
#pragma unroll
                for (int c = 0; c < 4; ++c) { const int r = 4 * lane + c; *(LAS u32x4*)(tb + r * 128 + ((wave ^ swz_f(r)) << 4)) = p[c]; }
                const int nit = it + G; const bool has_next = nit < CVT_NTILES;
                CvtTile nx = cvt_decode(has_next ? nit : 0, w_in, w_out, WIN, WOUT);
                if (has_next) {
#pragma unroll
                    for (int j = 0; j < 8; ++j) v[j] = __builtin_nontemporal_load((const f32x4*)(nx.src + (size_t)(8 * wave + j) * nx.ldw) + lane);
                }
                __syncthreads();
#pragma unroll
                for (int i = 0; i < 4; ++i) { const int r = (tid >> 3) + 64 * i, ch = tid & 7; const u32x4 o = *(const LAS u32x4*)(tb + r * 128 + ((ch ^ swz_f(r)) << 4));
                    *(u32x4*)(cur.dst + (size_t)(cur.n0 + r) * cur.ldt + 8 * ch) = o; }
                buf ^= 1; it = nit; cur = nx;
            }
            __syncthreads();
        }
        for (int i = bx * NTHREADS + tid; i < 4 * 65536; i += G * NTHREADS) { const int g = i >> 16, d = i & 255; WPOOL[i] = (bf16_t)f2bf(w_pool[i] * pool_scale[g * 256 + d]); }
        for (int i = bx * NTHREADS + tid; i < 48 * D; i += G * NTHREADS) { const int c = i / D, k = i % D; const float w = c < 4 ? w_rg[k * 4 + c] * g2[k] : (c < NRC ? w_re[k * 32 + (c - 4)] * g2[k] : 0.f);
            const unsigned hi = f2bf(w); const float wl = w - __builtin_bit_cast(float, hi << 16); WRTH[i] = (bf16_t)hi; WRTL[i] = (bf16_t)f2bf(wl); }
        for (int m = gw; m < T; m += NGW) {
            const f32x4* xr = (const f32x4*)(x + (size_t)m * D) + lane; f32x4 v[8]; float s = 0.f;
#pragma unroll
            for (int j = 0; j < 8; ++j) { v[j] = xr[64 * j]; s += (v[j].x * v[j].x + v[j].y * v[j].y) + (v[j].z * v[j].z + v[j].w * v[j].w); }
            const float rstd = 1.0f / sqrtf(wave_sum(s) * (1.0f / D) + EPS);
            u32x2* o = (u32x2*)(XN + (size_t)m * D) + lane;
#pragma unroll
            for (int j = 0; j < 8; ++j) { const f32x4 g = ((const f32x4*)g1)[64 * j + lane]; u32x2 w; w.x = pk2(v[j].x * rstd * g.x, v[j].y * rstd * g.y); w.y = pk2(v[j].z * rstd * g.z, v[j].w * rstd * g.w); o[64 * j] = w; }
        }
    }
    xcd_barrier(bar);
    }

    for (int rep_ = 0; rep_ < REP_P1; ++rep_) {
    {
        ProbDense P{XN, WIN, D, D, D, T / 256, INC / 256, G, bx};
        EpiBf16 E{PROJ, INC, nullptr, 0};
        pg8::gemm_phase<ProbDense, EpiBf16, true>(lds, P, E);
    }
    xcd_barrier(bar);
    }

    for (int rep_ = 0; rep_ < REP_P2; ++rep_) {
    {
        if (rep_ == 0) { ProbWeff P{WOUT, WPOOL, 256, D, 256, G, vcu}; EpiBf16 E{WOUT, D, nullptr, 1}; pg8::gemm_phase<ProbWeff, EpiBf16, false>(lds, P, E); }
        bf16_t* const POOLDST = MIXED; constexpr int POOLLD = D;
        for (int it = gw; it < 2048; it += NGW) {
            const int part = it >> 10, q = it & 1023, chunk = q >> 1, slab = q & 1, r0 = chunk * 16, c0 = slab * 512 + lane * 8;
#define BF8(v, f) { f[0] = bflo(v.x); f[1] = bfhi(v.x); f[2] = bflo(v.y); f[3] = bfhi(v.y); f[4] = bflo(v.z); f[5] = bfhi(v.z); f[6] = bflo(v.w); f[7] = bfhi(v.w); }
            if (part == 0) {
                const int gi = c0 >> 8, w = 2 << gi;
                float s[8];
#pragma unroll
                for (int j = 0; j < 8; ++j) s[j] = 0.f;
                { u32x4 iv[16];
#pragma unroll
                  for (int i = 0; i < 16; ++i) { const int rr = r0 - 1 - i; iv[i] = *(const u32x4*)(PROJ + (size_t)(rr < 0 ? 0 : rr) * INC + c0); }
#pragma unroll
                  for (int i = 0; i < 16; ++i) { const bool ok = (i < w) && (r0 - 1 - i >= 0); float f[8]; BF8(iv[i], f);
#pragma unroll
                      for (int j = 0; j < 8; ++j) s[j] += ok ? f[j] : 0.f; } }
#pragma unroll 1
                for (int tb = 0; tb < 2; ++tb) {
                    const int t0 = r0 + 8 * tb; u32x4 nv[8], ov[8];
#pragma unroll
                    for (int k = 0; k < 8; ++k) { nv[k] = *(const u32x4*)(PROJ + (size_t)(t0 + k) * INC + c0); const int ro = t0 + k - w; ov[k] = *(const u32x4*)(PROJ + (size_t)(ro < 0 ? 0 : ro) * INC + c0); }
#pragma unroll
                    for (int k = 0; k < 8; ++k) { const int t = t0 + k; float un[8], uo[8]; BF8(nv[k], un); BF8(ov[k], uo); const bool ok = t - w >= 0;
#pragma unroll
                        for (int j = 0; j < 8; ++j) s[j] += un[j] - (ok ? uo[j] : 0.f);
                        const int cn = (t + 1) < w ? (t + 1) : w; const float inv = 1.0f / (float)cn;
                        u32x4 p; p.x = pk2(s[0] * inv - un[0], s[1] * inv - un[1]); p.y = pk2(s[2] * inv - un[2], s[3] * inv - un[3]);
                        p.z = pk2(s[4] * inv - un[4], s[5] * inv - un[5]); p.w = pk2(s[6] * inv - un[6], s[7] * inv - un[7]);
                        *(u32x4*)(POOLDST + (size_t)t * POOLLD + c0) = p; }
                }
            } else {
                float cw[8][3];
#pragma unroll
                for (int j = 0; j < 8; ++j) { cw[j][0] = conv_w[(c0 + j) * 3 + 0]; cw[j][1] = conv_w[(c0 + j) * 3 + 1]; cw[j][2] = conv_w[(c0 + j) * 3 + 2]; }
                float z2[8], z1[8];
                { const int ra = r0 >= 2 ? r0 - 2 : 0, rb = r0 >= 1 ? r0 - 1 : 0;
                  const u32x4 ca = *(const u32x4*)(PROJ + (size_t)ra * INC + MIXA + MIXB + c0), va = *(const u32x4*)(PROJ + (size_t)ra * INC + MIXA + 2 * MIXB + c0);
                  const u32x4 cb = *(const u32x4*)(PROJ + (size_t)rb * INC + MIXA + MIXB + c0), vb = *(const u32x4*)(PROJ + (size_t)rb * INC + MIXA + 2 * MIXB + c0);
                  float fa[8], fb[8], fc[8], fd[8]; BF8(ca, fa); BF8(va, fb); BF8(cb, fc); BF8(vb, fd);
#pragma unroll
                  for (int j = 0; j < 8; ++j) { z2[j] = r0 >= 2 ? fa[j] * fb[j] : 0.f; z1[j] = r0 >= 1 ? fc[j] * fd[j] : 0.f; } }
#pragma unroll 1
                for (int tb = 0; tb < 2; ++tb) {
                    const int t0 = r0 + 8 * tb; u32x4 bbv[8], ccv[8], vvv[8];
#pragma unroll
                    for (int k = 0; k < 8; ++k) { const bf16_t* pr = PROJ + (size_t)(t0 + k) * INC + c0; bbv[k] = *(const u32x4*)(pr + MIXA); ccv[k] = *(const u32x4*)(pr + MIXA + MIXB); vvv[k] = *(const u32x4*)(pr + MIXA + 2 * MIXB); }
#pragma unroll
                    for (int k = 0; k < 8; ++k) { float bg[8], cg[8], vg[8]; BF8(bbv[k], bg); BF8(ccv[k], cg); BF8(vvv[k], vg); float yv[8];
#pragma unroll
                        for (int j = 0; j < 8; ++j) { const float z0 = cg[j] * vg[j]; yv[j] = bg[j] * (z2[j] * cw[j][0] + z1[j] * cw[j][1] + z0 * cw[j][2]); z2[j] = z1[j]; z1[j] = z0; }
                        u32x4 p; p.x = pk2(yv[0], yv[1]); p.y = pk2(yv[2], yv[3]); p.z = pk2(yv[4], yv[5]); p.w = pk2(yv[6], yv[7]);
                        *(u32x4*)(MIXED + (size_t)(t0 + k) * D + MIXA + c0) = p; }
                }
            }
#undef BF8
        }
    }
    xcd_barrier(bar);
    }

    for (int rep_ = 0; rep_ < REP_P4; ++rep_) {
    {
        ProbDense P{MIXED, WOUT, D, D, D, T / 256, D / 256, G, bx};
        EpiBf16 E{MIXO, D, nullptr, 0};
        pg8::gemm_phase<ProbDense, EpiBf16, false>(lds, P, E);
    }
    xcd_barrier(bar);
    }

    for (int rep_ = 0; rep_ < REP_P5; ++rep_) {
    {
        bf16_t* H2 = XN;
        for (int rb = vcu; rb < T / 32; rb += G) {
            const int row0 = rb * 32 + wave * 4;
            float rstd[4]; float mylog[4];
            LAS unsigned char* x1l = lds;
            {
                LAS float* ssp = (LAS float*)(lds + 131072);
                LAS float* rsd = ssp + 256;
                LAS float* red = (LAS float*)(lds + MISC_OFF + 4096);
                LAS float* lgs = red + 3 * 6 * 64 * 4;
                const int rowb = rb * 32, fr = lane & 15, fq = lane >> 4;
                f32x4 acc[2][3];
#pragma unroll
                for (int a = 0; a < 2; ++a)
#pragma unroll
                    for (int c = 0; c < 3; ++c) acc[a][c] = (f32x4){0.f, 0.f, 0.f, 0.f};
                float ssl[2] = {0.f, 0.f};
#pragma unroll 2
                for (int ks = 0; ks < 8; ++ks) {
                    const int k0 = 256 * wave + 32 * ks + 8 * fq;
                    bf16x8 bh[3], bl[3];
#pragma unroll
                    for (int c = 0; c < 3; ++c) { bh[c] = *(const bf16x8*)(WRTH + (size_t)(16 * c + fr) * D + k0); bl[c] = *(const bf16x8*)(WRTL + (size_t)(16 * c + fr) * D + k0); }
#pragma unroll
                    for (int a = 0; a < 2; ++a) { const size_t ro = (size_t)(rowb + 16 * a + fr) * D + k0;
                        const f32x4 xa = *(const f32x4*)(x + ro), xb = *(const f32x4*)(x + ro + 4); const u32x4 mo = *(const u32x4*)(MIXO + ro);
                        const float v[8] = {xa.x + bflo(mo.x), xa.y + bfhi(mo.x), xa.z + bflo(mo.y), xa.w + bfhi(mo.y), xb.x + bflo(mo.z), xb.y + bfhi(mo.z), xb.z + bflo(mo.w), xb.w + bfhi(mo.w)};
                        u32x4 hp, lp;
#pragma unroll
                        for (int q = 0; q < 4; ++q) { const unsigned h = cvt_pk_bf16(v[2 * q], v[2 * q + 1]); hp[q] = h; lp[q] = cvt_pk_bf16(v[2 * q] - bflo(h), v[2 * q + 1] - bfhi(h));
                            ssl[a] += v[2 * q] * v[2 * q] + v[2 * q + 1] * v[2 * q + 1]; }
                        *(LAS u32x4*)(x1l + (16 * a + fr) * 4096 + (((32 * wave + 4 * ks + fq) ^ fr) << 4)) = hp;
                        const bf16x8 ah = __builtin_bit_cast(bf16x8, hp), al = __builtin_bit_cast(bf16x8, lp);
#pragma unroll
                        for (int c = 0; c < 3; ++c) { acc[a][c] = __builtin_amdgcn_mfma_f32_16x16x32_bf16(ah, bh[c], acc[a][c], 0, 0, 0); acc[a][c] = __builtin_amdgcn_mfma_f32_16x16x32_bf16(ah, bl[c], acc[a][c], 0, 0, 0);
                            acc[a][c] = __builtin_amdgcn_mfma_f32_16x16x32_bf16(al, bh[c], acc[a][c], 0, 0, 0); } }
                }
#pragma unroll
                for (int a = 0; a < 2; ++a) { float s = ssl[a]; s += __shfl_xor(s, 16); s += __shfl_xor(s, 32); if (fq == 0) ssp[wave * 32 + 16 * a + fr] = s; }
                if (wave >= 4) {
#pragma unroll
                    for (int a = 0; a < 2; ++a)
#pragma unroll
                        for (int c = 0; c < 3; ++c) *(LAS f32x4*)(red + (((wave - 4) * 6 + a * 3 + c) * 64 + lane) * 4) = acc[a][c]; }
                __syncthreads();
                if (wave < 4) {
#pragma unroll
                    for (int a = 0; a < 2; ++a)
#pragma unroll
                        for (int c = 0; c < 3; ++c) acc[a][c] += *(const LAS f32x4*)(red + ((wave * 6 + a * 3 + c) * 64 + lane) * 4); }
                if (tid < 32) { float s = 0.f;
#pragma unroll
                    for (int w = 0; w < 8; ++w) s += ssp[w * 32 + tid];
                    rsd[tid] = 1.0f / sqrtf(s * (1.0f / D) + EPS); }
                __syncthreads();
                if (wave >= 1 && wave < 4) {
#pragma unroll
                    for (int a = 0; a < 2; ++a)
#pragma unroll
                        for (int c = 0; c < 3; ++c) *(LAS f32x4*)(red + (((wave - 1) * 6 + a * 3 + c) * 64 + lane) * 4) = acc[a][c]; }
                __syncthreads();
                if (wave == 0) {
#pragma unroll
                    for (int a = 0; a < 2; ++a)
#pragma unroll
                        for (int c = 0; c < 3; ++c) {
#pragma unroll
                            for (int w = 0; w < 3; ++w) acc[a][c] += *(const LAS f32x4*)(red + ((w * 6 + a * 3 + c) * 64 + lane) * 4);
#pragma unroll
                            for (int q = 0; q < 4; ++q) lgs[(16 * a + 4 * fq + q) * 48 + 16 * c + fr] = acc[a][c][q]; } }
                __syncthreads();
#pragma unroll
                for (int r = 0; r < 4; ++r) { rstd[r] = rsd[4 * wave + r]; mylog[r] = (lane < 48 ? lgs[(4 * wave + r) * 48 + lane] : 0.f) * rstd[r]; }
            }
#pragma unroll
            for (int j = 0; j < 4; ++j) { const int ci = 64 * j + lane; const f32x4 ga = ((const f32x4*)g2)[2 * ci], gb = ((const f32x4*)g2)[2 * ci + 1];
#pragma unroll
                for (int r = 0; r < 4; ++r) { const int row = 4 * wave + r; const u32x4 h = *(const LAS u32x4*)(x1l + row * 4096 + ((ci ^ (row & 15)) << 4));
                    const float sc = rstd[r] * tt8::SC_A;
                    u32x2 w; w.x = tt8::pack4_fp8(bflo(h.x) * sc * ga.x, bfhi(h.x) * sc * ga.y, bflo(h.y) * sc * ga.z, bfhi(h.y) * sc * ga.w);
                    w.y = tt8::pack4_fp8(bflo(h.z) * sc * gb.x, bfhi(h.z) * sc * gb.y, bflo(h.w) * sc * gb.z, bfhi(h.w) * sc * gb.w);
                    *(u32x2*)((unsigned char*)H2 + (size_t)(row0 + r) * D + 8 * ci) = w; } }
            const float bias = lane < 4 ? b_rg[lane] : (lane < NRC ? b_re[lane - 4] : 0.f);
#pragma unroll
            for (int r = 0; r < 4; ++r) {
                const float lg = mylog[r] + bias;
                float g[4];
#pragma unroll
                for (int i = 0; i < 4; ++i) g[i] = __shfl(lg, i);
                int grp = 0; float gm = g[0];
#pragma unroll
                for (int i = 1; i < 4; ++i) if (g[i] > gm) { gm = g[i]; grp = i; }
                float gs = 0.f;
#pragma unroll
                for (int i = 0; i < 4; ++i) gs += expf(g[i] - gm);
                const float g_w = 1.0f / gs;
                float el[8];
#pragma unroll
                for (int i = 0; i < 8; ++i) el[i] = __shfl(lg, 4 + grp * 8 + i);
                int i0 = 0; float m0 = el[0];
#pragma unroll
                for (int i = 1; i < 8; ++i) if (el[i] > m0) { m0 = el[i]; i0 = i; }
                int i1 = -1; float m1 = -3.0e38f;
#pragma unroll
                for (int i = 0; i < 8; ++i) if (i != i0 && el[i] > m1) { m1 = el[i]; i1 = i; }
                const float p1 = expf(m1 - m0);
                const float w0 = g_w / (1.0f + p1), w1 = g_w * p1 / (1.0f + p1);
                if (lane == 0) { const int a = (wave * 4 + r) * 2; misc[256 + a] = grp * 8 + i0; misc[256 + a + 1] = grp * 8 + i1;
                    misc[384 + a] = __builtin_bit_cast(int, w0); misc[384 + a + 1] = __builtin_bit_cast(int, w1); }
            }
            __syncthreads();
            if (wave == 0) {
                const int a = lane, tok = rb * 32 + (a >> 1), e = misc[256 + a];
                unsigned long long mym = 0ull;
#pragma unroll 1
                for (int ee = 0; ee < NE; ++ee) { const unsigned long long m = __ballot(e == ee); if (e == ee) mym = m; }
                const int rank = __popcll(mym & ((1ull << lane) - 1ull)), cntl = __popcll(mym), leader = __ffsll((long long)mym) - 1;
                int base = 0;
                if (rank == 0) base = (int)__hip_atomic_fetch_add(ctl + CW_ECNT + 64 * e + (rep_ == REP_P5 - 1 ? 0 : 32), (unsigned)cntl, RLX_AGENT);
                base = __shfl(base, leader);
                const int pos = base + rank;
                LIST[(size_t)e * T + pos] = tok;
                ((int*)ASG)[(size_t)tok * 4 + (a & 1) * 2] = e; ((int*)ASG)[(size_t)tok * 4 + (a & 1) * 2 + 1] = pos;
                ((int*)ASW)[(size_t)tok * 2 + (a & 1)] = misc[384 + a];
            }
            __syncthreads();
        }
    }
    xcd_barrier(bar);
    }

    for (int rep_ = 0; rep_ < REP_P67; ++rep_) {
    {
        const int nu = build_tt_units(misc, ctl, vcu, G);
        ProbTT8a P{(const unsigned char*)XN, w_gate, w_up, LIST, D, D, DE, misc + MISC_NUNIT + 8, nu};
        EpiTT8Swiglu E{(unsigned char*)HID, DE};
        for (int r6_ = 0; r6_ < REP_P6; ++r6_) { if (r6_) xcd_barrier(bar); tt8::gemm_phase<ProbTT8a, EpiTT8Swiglu>(lds, P, E); }
    }
    xcd_barrier(bar);

    {
        const int nu = build_tt_units(misc, ctl, vcu, G);
        ProbTT8b P{(const unsigned char*)HID, w_down, DE, DE, D, misc + MISC_NUNIT + 8, nu};
        EpiTT8Y E{Y, D};
        for (int r7_ = 0; r7_ < REP_P7; ++r7_) { if (r7_) xcd_barrier(bar); tt8::gemm_phase<ProbTT8b, EpiTT8Y>(lds, P, E); }
    }
    xcd_barrier(bar);

    }
    for (int rep_ = 0; rep_ < REP_P8; ++rep_) {
    if (rep_) xcd_barrier(bar);
    {
        volatile LAS int* pst = misc + MISC_ETAB + 64;
        for (int m = gw; m < T; m += NGW) {
            const i32x4 as = ASG[m]; const f32x2 aw = ASW[m];
            const int s0 = pst[as.x] + as.y, s1 = pst[as.z] + as.w;
            const f32x4* xr = (const f32x4*)(x + (size_t)m * D) + lane; const u32x2* mo_ = (const u32x2*)(MIXO + (size_t)m * D) + lane; const u32x2* y0 = (const u32x2*)(Y + (size_t)s0 * D) + lane; const u32x2* y1 = (const u32x2*)(Y + (size_t)s1 * D) + lane;
            f32x4 v[8]; float s = 0.f;
#pragma unroll
            for (int j = 0; j < 8; ++j) { f32x4 xx = xr[64 * j]; const u32x2 a = y0[64 * j], b = y1[64 * j], mo = mo_[64 * j];
                xx.x += bflo(mo.x); xx.y += bfhi(mo.x); xx.z += bflo(mo.y); xx.w += bfhi(mo.y);
                v[j].x = xx.x + aw.x * bflo(a.x) + aw.y * bflo(b.x); v[j].y = xx.y + aw.x * bfhi(a.x) + aw.y * bfhi(b.x);
                v[j].z = xx.z + aw.x * bflo(a.y) + aw.y * bflo(b.y); v[j].w = xx.w + aw.x * bfhi(a.y) + aw.y * bfhi(b.y);
                s += (v[j].x * v[j].x + v[j].y * v[j].y) + (v[j].z * v[j].z + v[j].w * v[j].w); }
            const float rstd = 1.0f / sqrtf(wave_sum(s) * (1.0f / D) + EPS);
            f32x4* o = (f32x4*)(out + (size_t)m * D) + lane;
#pragma unroll
            for (int j = 0; j < 8; ++j) { const f32x4 g = ((const f32x4*)g3)[64 * j + lane]; o[64 * j] = (f32x4){v[j].x * rstd * g.x, v[j].y * rstd * g.y, v[j].z * rstd * g.z, v[j].w * rstd * g.w}; }
        }
    }
    }
}

extern "C" void kernel_launch(void* const* d_in, const int* in_sizes, int n_in, void* d_out, int out_size, void* d_ws, size_t ws_size, hipStream_t stream) {
    static int grid = 0;
    if (grid == 0) {
        if (n_in != 16 || in_sizes[0] != T * D || out_size != T * D || ws_size < WS_END) { fprintf(stderr, "kernel_launch: unexpected shapes (n_in %d, in0 %d, out %d, ws %zu); nothing launched\n", n_in, n_in > 0 ? in_sizes[0] : -1, out_size, ws_size); grid = -1; return; }
        int dev = 0, cus = 0, per_cu = 0;
        if (hipGetDevice(&dev) != hipSuccess || hipDeviceGetAttribute(&cus, hipDeviceAttributeMultiprocessorCount, dev) != hipSuccess) { fprintf(stderr, "kernel_launch: device query failed\n"); grid = -1; return; }
        if (hipFuncSetAttribute((const void*)fwd_kernel, hipFuncAttributeMaxDynamicSharedMemorySize, LDS_BYTES) != hipSuccess) { fprintf(stderr, "kernel_launch: hipFuncSetAttribute failed\n"); grid = -1; return; }
        if (hipOccupancyMaxActiveBlocksPerMultiprocessor(&per_cu, (const void*)fwd_kernel, NTHREADS, LDS_BYTES) != hipSuccess || per_cu < 1) { fprintf(stderr, "kernel_launch: occupancy query says %d blocks per CU; nothing launched\n", per_cu); (void)hipGetLastError(); grid = -1; return; }
        grid = cus;
    }
    if (grid < 0) return;
    if (hipMemsetAsync((char*)d_ws + WS_CTL, 0, CTL_BYTES, stream) != hipSuccess) { fprintf(stderr, "kernel_launch: memset failed\n"); return; }
    Args a{};
    for (int i = 0; i < 16; ++i) a.in[i] = (const float*)d_in[i];
    a.out = (float*)d_out; a.ws = (unsigned char*)d_ws;
    void* kargs[] = {&a};
    hipError_t le = hipLaunchCooperativeKernel((const void*)fwd_kernel, dim3(grid), dim3(NTHREADS), kargs, LDS_BYTES, stream);
    if (le != hipSuccess) fprintf(stderr, "kernel_launch: cooperative launch failed: %s (grid %d)\n", hipGetErrorString(le), grid);
}
```
